# Optimizing an MI355X kernel written in HIP

```python
import math
import jax
import jax.numpy as jnp
from jax import lax
import numpy as np

D_MODEL = 1024
BATCH = 8
SEQ = 4096
DEPTH = 4

CTX_LEN = 256
GRID_W = 64

HG_WIDTH = D_MODEL // 4
HG_HEADS = 4
HG_DK = HG_WIDTH // HG_HEADS
HG_DV = HG_WIDTH // HG_HEADS
HG_CHUNK = 64
HG_COLS = 5 * HG_WIDTH

DA_WIDTH = D_MODEL // 2
DA_HEADS = 4
DA_DV = DA_WIDTH // DA_HEADS
DA_DQK = DA_DV // 2
DA_COLS = 3 * DA_WIDTH
Q_BLOCK = 128
ROPE_BASE = 10000.0

RW_WIDTH = D_MODEL - HG_WIDTH - DA_WIDTH
RW_HEADS = 4
RW_DH = RW_WIDTH // RW_HEADS
RW_DECAY_RANK = 32
RW_ICLR_RANK = 32
RW_GATE_RANK = 64
RW_COLS = 3 * RW_WIDTH + 2 * RW_DECAY_RANK + 2 * RW_ICLR_RANK + RW_GATE_RANK
RW_GN_EPS = 64e-5

MIX_WIDTH = HG_WIDTH + DA_WIDTH + RW_WIDTH
IN_COLS = HG_COLS + DA_COLS + RW_COLS
D_FF = -(-8 * D_MODEL // (3 * 256)) * 256

kernel_name = 'hybrid_hgrn2_diffattn_rwkv7_dit_block'

F32 = jnp.float32


def rms_norm(x, gain, eps=1e-6):
    xf = x.astype(F32)
    y = xf * lax.rsqrt(jnp.mean(xf * xf, axis=-1, keepdims=True) + eps)
    return (y * gain.astype(F32)).astype(x.dtype)


def modulate(h, shift, scale):
    return h * (1.0 + scale) + shift


def swiglu(h, w_gate, w_up, w_down):
    return (jax.nn.silu(h @ w_gate) * (h @ w_up)) @ w_down


def direction_order(t, n_ctx, reverse):
    if not reverse:
        return t
    return jnp.concatenate([t[:, :n_ctx][:, ::-1], t[:, n_ctx:][:, ::-1]], axis=1)


def centred_token_shift(z, mu_prev, mu_next):
    z_prev = jnp.pad(z, ((0, 0), (1, 0), (0, 0)))[:, :-1]
    z_next = jnp.pad(z, ((0, 0), (0, 1), (0, 0)))[:, 1:]
    return z + mu_prev * (z_prev - z) + mu_next * (z_next - z)


def axial_rope(n_tokens, dim):
    n_rows = n_tokens // GRID_W
    rows = jnp.repeat(jnp.arange(n_rows, dtype=F32), GRID_W)
    cols = jnp.tile(jnp.arange(GRID_W, dtype=F32), n_rows)
    n_freq = dim // 4
    inv_freq = ROPE_BASE ** (-jnp.arange(n_freq, dtype=F32) / n_freq)
    ang = jnp.concatenate([rows[:, None] * inv_freq, cols[:, None] * inv_freq], axis=-1)
    return jnp.cos(ang), jnp.sin(ang)


def apply_rope(t, cos, sin):
    half = t.shape[-1] // 2
    shape = (1, cos.shape[0]) + (1,) * (t.ndim - 3) + (half,)
    cos = cos.reshape(shape).astype(t.dtype)
    sin = sin.reshape(shape).astype(t.dtype)
    t1, t2 = t[..., :half], t[..., half:]
    return jnp.concatenate([t1 * cos - t2 * sin, t1 * sin + t2 * cos], axis=-1)


def head_group_norm(y, w, b, eps):
    mean = jnp.mean(y, axis=-1, keepdims=True)
    var = jnp.mean(jnp.square(y - mean), axis=-1, keepdims=True)
    yn = (y - mean) * lax.rsqrt(var + eps)
    return yn.reshape(y.shape[0], y.shape[1], -1) * w + b


def hgrn2_chunk_scan(q, k, v, log_f):
    B, N, H, Dk = q.shape
    Dv = v.shape[-1]
    nc = N // HG_CHUNK

    def chunks(t):
        return jnp.moveaxis(t.reshape(B, nc, HG_CHUNK, H, t.shape[-1]), (1, 3), (0, 2))

    prefix = jnp.tril(jnp.ones((HG_CHUNK, HG_CHUNK), dtype=bool))[:, :, None]

    def step(S, inp):
        q_c, k_c, v_c, g_c = inp
        b = jnp.cumsum(g_c, axis=2)
        rel = jnp.where(prefix, b[:, :, :, None, :] - b[:, :, None, :, :], -jnp.inf)
        att = jnp.einsum('bhtk,bhsk,bhtsk->bhts', q_c, k_c, jnp.exp(rel))
        o = (jnp.einsum('bhts,bhsv->bhtv', att, v_c)
             + jnp.einsum('bhtk,bhkv->bhtv', q_c * jnp.exp(b), S))
        b_end = b[:, :, -1:, :]
        S = (S * jnp.exp(b_end)[:, :, 0, :, None]
             + jnp.einsum('bhsk,bhsv->bhkv', k_c * jnp.exp(b_end - b), v_c))
        return S, o

    S0 = jnp.zeros((B, H, Dk, Dv), F32)
    _, o = lax.scan(step, S0, tuple(chunks(t) for t in (q, k, v, log_f)))
    return jnp.moveaxis(o, (0, 2), (1, 3)).reshape(B, N, H, Dv)


def rwkv7_scan(r, w, k, v, a, b):
    B, N, H, Dh = r.shape

    def step(S, inp):
        r_t, w_t, k_t, v_t, a_t, b_t = inp
        sa = jnp.einsum('bhvk,bhk->bhv', S, a_t)
        S = (S * w_t[:, :, None, :] + sa[..., None] * b_t[:, :, None, :]
             + v_t[..., None] * k_t[:, :, None, :])
        return S, jnp.einsum('bhvk,bhk->bhv', S, r_t)

    xs = tuple(jnp.moveaxis(t, 1, 0) for t in (r, w, k, v, a, b))
    _, y = lax.scan(step, jnp.zeros((B, H, Dh, Dh), F32), xs)
    return jnp.moveaxis(y, 0, 1)


def hgrn2_mixer(uc, ux, lower_bound, norm_g):
    n_ctx = uc.shape[1]
    u = jnp.concatenate([uc, ux], axis=1).astype(F32)
    B, N, _ = u.shape
    heads = lambda t: t.reshape(B, N, HG_HEADS, -1)
    q, inp, f_fwd, f_bwd, g = (heads(t) for t in jnp.split(u, 5, axis=-1))
    outs = []
    for f_logit, lb, rev in ((f_fwd, lower_bound[0], False), (f_bwd, lower_bound[1], True)):
        lb = lb.reshape(HG_HEADS, HG_DK).astype(F32)
        f = lb + (1.0 - lb) * jax.nn.sigmoid(f_logit)
        o = hgrn2_chunk_scan(*(direction_order(t, n_ctx, rev) for t in (q, 1.0 - f, inp, jnp.log(f))))
        outs.append(direction_order(o, n_ctx, rev))
    o = rms_norm(outs[0] + outs[1], norm_g) * jax.nn.silu(g)
    o = o.reshape(B, N, HG_WIDTH).astype(ux.dtype)
    return o[:, :n_ctx], o[:, n_ctx:]


def diff_attention_mixer(uc, ux, lam, lam_init, norm_g, cos, sin, with_ctx_queries):
    B, L, _ = uc.shape
    T = ux.shape[1]
    scale = DA_DQK ** -0.5

    def split_heads(u):
        n = u.shape[1]
        q, k, v = jnp.split(u, 3, axis=-1)
        return (q.reshape(B, n, DA_HEADS, 2, DA_DQK), k.reshape(B, n, DA_HEADS, 2, DA_DQK),
                v.reshape(B, n, DA_HEADS, DA_DV))

    qc, kc, vc = split_heads(uc)
    qx, kx, vx = split_heads(ux)
    qx, kx = apply_rope(qx, cos, sin), apply_rope(kx, cos, sin)
    hm = lambda t: jnp.moveaxis(t, 1, 2)
    k_all = hm(jnp.concatenate([kc, kx], axis=1))
    v_all = hm(jnp.concatenate([vc, vx], axis=1))

    def attend(q, k, v):
        s = jnp.einsum('bhqmd,bhsmd->bhmqs', q, k).astype(F32) * scale
        p = jax.nn.softmax(s, axis=-1)
        p = p[:, :, 0] - lam * p[:, :, 1]
        return jnp.einsum('bhqs,bhsv->bhqv', p.astype(v.dtype), v)

    def finish(o):
        o = rms_norm(o, norm_g) * (1.0 - lam_init)
        return hm(o).reshape(B, o.shape[2], DA_WIDTH)

    nb = T // Q_BLOCK
    qb = jnp.moveaxis(hm(qx).reshape(B, DA_HEADS, nb, Q_BLOCK, 2, DA_DQK), 2, 0)
    ox = lax.map(lambda qq: attend(qq, k_all, v_all), qb)
    ox = jnp.moveaxis(ox, 0, 2).reshape(B, DA_HEADS, T, DA_DV)
    oc = finish(attend(hm(qc), hm(kc), hm(vc))) if with_ctx_queries else None
    return oc, finish(ox)


def rwkv7_mixer(uc, ux, mu_prev, mu_next, w0, w2, a0, a2, g2, k_k, k_a, r_k, ln_w, ln_b):
    n_ctx = uc.shape[1]
    u = jnp.concatenate([centred_token_shift(uc, mu_prev, mu_next),
                         centred_token_shift(ux, mu_prev, mu_next)], axis=1).astype(F32)
    B, N, _ = u.shape
    W = RW_WIDTH
    sizes = (W, W, W, RW_DECAY_RANK, RW_DECAY_RANK, RW_ICLR_RANK, RW_ICLR_RANK, RW_GATE_RANK)
    r, k, v, wd_f, wd_b, ad_f, ad_b, gd = jnp.split(u, np.cumsum(sizes)[:-1].tolist(), axis=-1)
    heads = lambda t: t.reshape(B, N, RW_HEADS, RW_DH)
    gate = jax.nn.sigmoid(gd) @ g2
    kk = heads(k * k_k)
    kk = kk * lax.rsqrt(jnp.maximum(jnp.sum(kk * kk, axis=-1, keepdims=True), 1e-24))
    rh, vh = heads(r), heads(v)
    r_k = r_k.reshape(RW_HEADS, RW_DH)
    ys, bonuses = [], []
    for d, (wd, ad, rev) in enumerate(((wd_f, ad_f, False), (wd_b, ad_b, True))):
        w_log = -jax.nn.softplus(-(w0[d] + jnp.tanh(wd) @ w2[d])) - 0.5
        decay = heads(jnp.exp(-jnp.exp(w_log)))
        a = jax.nn.sigmoid(a0[d] + ad @ a2[d])
        kd = heads(k * (1.0 + (a - 1.0) * k_a))
        a = heads(a)
        y = rwkv7_scan(*(direction_order(t, n_ctx, rev) for t in (rh, decay, kd, vh, -kk, kk * a)))
        ys.append(direction_order(y, n_ctx, rev))
        bonuses.append(jnp.sum(rh * kd * r_k, axis=-1, keepdims=True) * vh)
    y = head_group_norm(ys[0] + ys[1], ln_w, ln_b, RW_GN_EPS) + (bonuses[0] + bonuses[1]).reshape(B, N, W)
    o = (y * gate).astype(ux.dtype)
    return o[:, :n_ctx], o[:, n_ctx:]


def setup_inputs(seed: int = 0) -> dict:
    key = jax.random.key(seed)
    keys = list(jax.random.split(key, 40))
    D = D_MODEL

    def nrm(shape, s):
        return jax.random.normal(keys.pop(), shape, F32) * s

    def uni(shape, s):
        return jax.random.uniform(keys.pop(), shape, F32) * s

    return {
        'x': nrm((BATCH, SEQ, D), 1.0),
        'c': nrm((BATCH, D), 1.0),
        'ctx': nrm((BATCH, CTX_LEN, D), 1.0),
        'c_ctx': nrm((D,), 1.0),
        'ada_w': nrm((DEPTH, D, 6 * D), 0.5 * D ** -0.5),
        'ada_b': nrm((DEPTH, 6 * D), 0.02),
        'norm1_g': 1.0 + nrm((DEPTH, D), 0.02),
        'norm2_g': 1.0 + nrm((DEPTH, D), 0.02),
        'w_in': nrm((DEPTH, D, IN_COLS), D ** -0.5),
        'w_out': nrm((DEPTH, MIX_WIDTH, D), MIX_WIDTH ** -0.5),
        'hg_lb_logits': nrm((2, DEPTH, HG_HEADS * HG_DK), 0.5),
        'hg_norm_g': 1.0 + nrm((DEPTH, HG_DV), 0.02),
        'da_lam_q1': nrm((DEPTH, DA_DQK), 0.1),
        'da_lam_k1': nrm((DEPTH, DA_DQK), 0.1),
        'da_lam_q2': nrm((DEPTH, DA_DQK), 0.1),
        'da_lam_k2': nrm((DEPTH, DA_DQK), 0.1),
        'da_norm_g': 1.0 + nrm((DEPTH, DA_DV), 0.02),
        'rw_mu_prev': uni((DEPTH, RW_COLS), 0.5),
        'rw_mu_next': uni((DEPTH, RW_COLS), 0.5),
        'rw_w0': nrm((2, DEPTH, RW_WIDTH), 0.5),
        'rw_w2': nrm((2, DEPTH, RW_DECAY_RANK, RW_WIDTH), 0.1),
        'rw_a0': nrm((2, DEPTH, RW_WIDTH), 0.1),
        'rw_a2': nrm((2, DEPTH, RW_ICLR_RANK, RW_WIDTH), 0.5 * RW_ICLR_RANK ** -0.5),
        'rw_g2': nrm((DEPTH, RW_GATE_RANK, RW_WIDTH), RW_GATE_RANK ** -0.5),
        'rw_k_k': 0.85 + nrm((DEPTH, RW_WIDTH), 0.05),
        'rw_k_a': 1.0 + nrm((DEPTH, RW_WIDTH), 0.05),
        'rw_r_k': nrm((DEPTH, RW_WIDTH), 0.1),
        'rw_ln_w': 1.0 + nrm((DEPTH, RW_WIDTH), 0.02),
        'rw_ln_b': nrm((DEPTH, RW_WIDTH), 0.02),
        'ffn_w_gate': nrm((DEPTH, D, D_FF), D ** -0.5),
        'ffn_w_up': nrm((DEPTH, D, D_FF), D ** -0.5),
        'ffn_w_down': nrm((DEPTH, D_FF, D), D_FF ** -0.5),
        'final_norm_g': 1.0 + nrm((D,), 0.02),
    }


def reference(x, c, ctx, c_ctx, ada_w, ada_b, norm1_g, norm2_g, w_in, w_out,
              hg_lb_logits, hg_norm_g, da_lam_q1, da_lam_k1, da_lam_q2, da_lam_k2, da_norm_g,
              rw_mu_prev, rw_mu_next, rw_w0, rw_w2, rw_a0, rw_a2, rw_g2, rw_k_k, rw_k_a,
              rw_r_k, rw_ln_w, rw_ln_b, ffn_w_gate, ffn_w_up, ffn_w_down, final_norm_g):
    T = x.shape[1]
    cos, sin = axial_rope(T, DA_DQK)
    p_lb = jax.nn.softmax(hg_lb_logits.astype(F32), axis=1)
    lower_bounds = jnp.cumsum(p_lb, axis=1) - p_lb[:, :1]
    silu_c = jax.nn.silu(c)
    silu_cc = jax.nn.silu(c_ctx)
    for l in range(DEPTH):
        last = l == DEPTH - 1
        mod_x = (silu_c @ ada_w[l] + ada_b[l])[:, None, :]
        mod_c = silu_cc @ ada_w[l] + ada_b[l]
        sh1x, sc1x, g1x, sh2x, sc2x, g2x = jnp.split(mod_x, 6, axis=-1)
        sh1c, sc1c, g1c, sh2c, sc2c, g2c = jnp.split(mod_c, 6, axis=-1)

        hx = modulate(rms_norm(x, norm1_g[l]), sh1x, sc1x)
        hc = modulate(rms_norm(ctx, norm1_g[l]), sh1c, sc1c)
        ux = hx @ w_in[l]
        uc = hc @ w_in[l]
        cut = [HG_COLS, HG_COLS + DA_COLS]
        ux_hg, ux_da, ux_rw = jnp.split(ux, cut, axis=-1)
        uc_hg, uc_da, uc_rw = jnp.split(uc, cut, axis=-1)

        hg_c, hg_x = hgrn2_mixer(uc_hg, ux_hg, lower_bounds[:, l], hg_norm_g[l])

        lam_init = 0.8 - 0.6 * math.exp(-0.3 * l)
        lam = (jnp.exp(jnp.sum(da_lam_q1[l] * da_lam_k1[l]))
               - jnp.exp(jnp.sum(da_lam_q2[l] * da_lam_k2[l])) + lam_init).astype(F32)
        da_c, da_x = diff_attention_mixer(uc_da, ux_da, lam, lam_init, da_norm_g[l], cos, sin,
                                          not last)

        rw_c, rw_x = rwkv7_mixer(uc_rw, ux_rw, rw_mu_prev[l], rw_mu_next[l], rw_w0[:, l], rw_w2[:, l],
                                 rw_a0[:, l], rw_a2[:, l], rw_g2[l], rw_k_k[l], rw_k_a[l], rw_r_k[l],
                                 rw_ln_w[l], rw_ln_b[l])

        x = x + g1x * (jnp.concatenate([hg_x, da_x, rw_x], axis=-1) @ w_out[l])
        hx2 = modulate(rms_norm(x, norm2_g[l]), sh2x, sc2x)
        x = x + g2x * swiglu(hx2, ffn_w_gate[l], ffn_w_up[l], ffn_w_down[l])

        if not last:
            ctx = ctx + g1c * (jnp.concatenate([hg_c, da_c, rw_c], axis=-1) @ w_out[l])
            hc2 = modulate(rms_norm(ctx, norm2_g[l]), sh2c, sc2c)
            ctx = ctx + g2c * swiglu(hc2, ffn_w_gate[l], ffn_w_up[l], ffn_w_down[l])
    return rms_norm(x, final_norm_g)
```

```cpp
#include <hip/hip_runtime.h>
#include <hip/hip_cooperative_groups.h>
#include <cstdio>
namespace cg = cooperative_groups;

#define DI __device__ __forceinline__
#define LAS __attribute__((address_space(3)))
typedef _Float16 half_t;
typedef _Float16 h8 __attribute__((ext_vector_type(8)));
typedef _Float16 h4 __attribute__((ext_vector_type(4)));
typedef _Float16 h2 __attribute__((ext_vector_type(2)));
typedef float f32x4 __attribute__((ext_vector_type(4)));
typedef float f32x16 __attribute__((ext_vector_type(16)));
typedef short s4v __attribute__((__vector_size__(8)));

constexpr int DM = 1024, NB = 8, TLAT = 4096, LCTX = 256, NTOK = 4352, MROWS = NB * NTOK, DEPTH = 4;
constexpr int INC = 3776, UST = 3840, DFF = 2816, RWC = 3072;
constexpr int U_HGQ = 0, U_HGI = 256, U_HGKF = 512, U_HGG = 1024, U_DAQ = 1280, U_DAK = 1792, U_DAV = 2304, U_RW = 2816;
constexpr int U_YF = 2816, U_OF = 3328, U_MIX = 1024, U_MIXRW = 1792;
constexpr int R_V = 2560, R_GATE = 2816;
constexpr size_t OFF_U = 0, SZ_U = (size_t)MROWS * UST * 2;
constexpr size_t OFF_BC = OFF_U + SZ_U, SZ_BC = (size_t)MROWS * RWC * 2;
constexpr size_t OFF_WIN = OFF_BC + SZ_BC, SZ_WIN = (size_t)UST * DM * 2;
constexpr size_t OFF_WOUT = OFF_WIN + SZ_WIN, SZ_WOUT = (size_t)DM * DM * 2;
constexpr size_t OFF_WGU = OFF_WOUT + SZ_WOUT, SZ_WGU = (size_t)2 * DFF * DM * 2;
constexpr size_t OFF_WDN = OFF_WGU + SZ_WGU, SZ_WDN = (size_t)DM * DFF * 2;
constexpr size_t OFF_XC = OFF_WDN + SZ_WDN, SZ_XC = (size_t)NB * LCTX * DM * 4;
constexpr size_t OFF_MOD = OFF_XC + SZ_XC, SZ_MOD = (size_t)DEPTH * 9 * 6 * DM * 4;
constexpr size_t OFF_LB = OFF_MOD + SZ_MOD, SZ_LB = (size_t)DEPTH * 2 * 256 * 4;
constexpr size_t OFF_LAM = OFF_LB + SZ_LB, SZ_LAM = 256;
constexpr size_t OFF_ROPE = OFF_LAM + SZ_LAM, SZ_ROPE = 64 * 16 * 8;
constexpr size_t OFF_CB = OFF_ROPE + SZ_ROPE, SZ_CB = (size_t)MROWS * 4 * 4;
constexpr size_t OFF_BAR = OFF_CB + SZ_CB, SZ_BAR = 3456 * 4;
constexpr size_t OFF_PCB = OFF_BAR + SZ_BAR, SZ_PCB = (size_t)(MROWS / 16) * 512 * 2;
constexpr size_t WS_END = OFF_PCB + SZ_PCB;
constexpr size_t OFF_PART = OFF_BC + ((size_t)MROWS * DM * 2 + 4096), SZ_PART1 = (size_t)NB * LCTX * DM * 4;
constexpr int LDS_BYTES = 131072;
constexpr float QSCALE = 0.125f * 1.4426950408889634f;

struct Params { const float* in[33]; float* out; unsigned char* ws; };
enum { I_X = 0, I_C, I_CTX, I_CCTX, I_ADAW, I_ADAB, I_N1G, I_N2G, I_WIN, I_WOUT, I_HGLB, I_HGNG, I_LQ1, I_LK1, I_LQ2, I_LK2, I_DANG, I_MUP, I_MUN,
       I_W0, I_W2, I_A0, I_A2, I_G2, I_KK, I_KA, I_RK, I_LNW, I_LNB, I_FG, I_FU, I_FD, I_FNG };

DI int ltid() { int t = threadIdx.x; asm volatile("" : "+v"(t)); return t; }
DI float wave_sum(float v) {
#pragma unroll
    for (int o = 32; o; o >>= 1) v += __shfl_xor(v, o);
    return v;
}
DI float dpp_add(float v, const int ctrl_unused) { return v; }
#define DPP_ADD(v, ctrl) ((v) + __int_as_float(__builtin_amdgcn_mov_dpp(__float_as_int(v), (ctrl), 0xf, 0xf, true)))
DI float row16_sum(float v) {
    v = DPP_ADD(v, 0xB1);
    v = DPP_ADD(v, 0x4E);
    v = DPP_ADD(v, 0x124);
    v = DPP_ADD(v, 0x128);
    return v;
}
DI float sigmoidf_(float x) { return __builtin_amdgcn_rcpf(1.f + __expf(-x)); }

DI const float* xsrc_row(const Params& p, int l, int m) {
    const int b = m / NTOK, n = m - b * NTOK;
    if (n < LCTX) return (l == 0 ? p.in[I_CTX] : (const float*)(p.ws + OFF_XC)) + ((size_t)b * LCTX + n) * DM;
    return (l == 0 ? p.in[I_X] : (const float*)p.out) + ((size_t)b * TLAT + (n - LCTX)) * DM;
}

namespace pg8 {
constexpr int BM = 256, BK = 64, HALF = 128, HTB = HALF * BK * 2, STAGE_BYTES = 8 * HTB, NXCD = 8, WGM = 8;
DI int lds_byte(int r, int c) { const int st = (r >> 4) * 2 + (c >> 5), rr = r & 15, cc = c & 31, ob = rr * 64 + cc * 2; return st * 1024 + (ob ^ (((ob >> 9) & 1) << 5)); }
DI void stage_rc(int b, int& R, int& C) { const int st = b / 1024, sb = b % 1024, swz = sb ^ (((sb >> 9) & 1) << 5); R = (st >> 1) * 16 + swz / 64; C = (st & 1) * 32 + (swz % 64) / 2; }
DI int perm32(int rho) { const int n = rho >> 4, i = rho & 15; return 8 * (i >> 2) + 4 * n + (i & 3); }
struct Unit { int pm, pn; };
struct Gemm { const half_t* A; const half_t* Bt; int M, N, K, lda, ldb; };
struct StaticOrder {
    int nM, nN, nwg, G, c, skipctx;
    DI void init(int M, int N, int G_, int c_, int skipctx_ = 0) { nM = M / BM; if (skipctx_) nM -= nM / 17; nN = N / BM; nwg = nM * nN; G = G_; c = c_; skipctx = skipctx_; }
    DI bool next(int i, Unit& u) const {
        const long L = (long)i * G + c; if (L >= nwg) return false;
        int wgid = (int)L; { const int q = nwg / NXCD, r = nwg % NXCD, xcd = wgid % NXCD, off = wgid / NXCD; wgid = (xcd < r ? xcd * (q + 1) : r * (q + 1) + (xcd - r) * q) + off; }
        const int nig = WGM * nN, gid = wgid / nig, fm = gid * WGM, gsz = (nM - fm) < WGM ? (nM - fm) : WGM;
        u.pm = fm + ((wgid % nig) % gsz); u.pn = (wgid % nig) / gsz; if (skipctx) u.pm += u.pm / 16 + 1; return true;
    }
};

struct OneUnit { Unit u; DI bool next(int i, Unit& o) const { o = u; return i == 0; } };
template <class Epi, class Sched>
DI void gemm_phase(LAS unsigned char* lds, const Gemm g, const Sched& S, const Epi& E) {
    const int tid = ltid(), wid = __builtin_amdgcn_readfirstlane(tid >> 6), lane = tid & 63, wr = wid >> 2, wc = wid & 3, fr = lane & 15, fq = lane >> 4;
    const int K = g.K, nt = K / BK, lda = g.lda, ldb = g.ldb ? g.ldb : g.K;
    unsigned voffA[2], voffB[2];
#pragma unroll
    for (int i = 0; i < 2; ++i) { int R, C; stage_rc(tid * 16 + i * 8192, R, C); const int Rb = Epi::PERM ? ((R & ~31) + perm32(R & 31)) : R;
        voffA[i] = (unsigned)(R * lda + C) * 2u; voffB[i] = (unsigned)(Rb * ldb + C) * 2u; }
    const size_t kstep = (size_t)(BK * 2);
    const size_t hstepA = (size_t)HALF * lda * 2, hstepB = (size_t)HALF * ldb * 2;
    const size_t tstepA = 2 * hstepA, tstepB = 2 * hstepB;
    const unsigned ldsw = (unsigned)wid * 1024u;
    const int aoff = lds_byte(wr * 64 + fr, fq * 8), boff = lds_byte(wc * 32 + fr, fq * 8);
#define PG8_SA(b, h) (((b) * 2 + (h)) * HTB)
#define PG8_SB(b, h) ((4 + (b) * 2 + (h)) * HTB)
#define PG8_STAGE(bufoff, gbase, voff) do { _Pragma("unroll") for (int _i = 0; _i < 2; ++_i) \
        __builtin_amdgcn_global_load_lds((const unsigned*)((const char*)(gbase) + (voff)[_i]), (LAS unsigned*)(lds + (bufoff) + ldsw + _i * 8192), 16, 0, 0); } while (0)
#define PG8_LDA(dst, b, h) do { _Pragma("unroll") for (int m = 0; m < 4; ++m) _Pragma("unroll") for (int k = 0; k < 2; ++k) dst[m][k] = *(const LAS h8*)(lds + PG8_SA(b, h) + aoff + m * 2048 + k * 1024); } while (0)
#define PG8_LDB(dst, b, h) do { _Pragma("unroll") for (int n = 0; n < 2; ++n) _Pragma("unroll") for (int k = 0; k < 2; ++k) dst[n][k] = *(const LAS h8*)(lds + PG8_SB(b, h) + boff + n * 2048 + k * 1024); } while (0)
#define PG8_MMA(ai, bj, At, Bt) do { __builtin_amdgcn_s_setprio(1); _Pragma("unroll") for (int m = 0; m < 4; ++m) _Pragma("unroll") for (int n = 0; n < 2; ++n) _Pragma("unroll") for (int k = 0; k < 2; ++k) \
        acc[ai][bj][m][n] = __builtin_amdgcn_mfma_f32_16x16x32_f16(Bt[n][k], At[m][k], acc[ai][bj][m][n], 0, 0, 0); __builtin_amdgcn_s_setprio(0); } while (0)
#define PG8_WAIT_V(n) asm volatile("s_waitcnt vmcnt(" #n ")" ::: "memory")
#define PG8_WAIT_L(n) asm volatile("s_waitcnt lgkmcnt(" #n ")" ::: "memory")
#define PG8_BAR __builtin_amdgcn_s_barrier()
#define PG8_SCHED __builtin_amdgcn_sched_barrier(0)
    Unit cur, nxt; int ui = 0;
    if (!S.next(0, cur)) return;
    f32x4 acc[2][2][4][2];
#pragma unroll
    for (int a = 0; a < 2; ++a)
#pragma unroll
        for (int b = 0; b < 2; ++b)
#pragma unroll
            for (int m = 0; m < 4; ++m)
#pragma unroll
                for (int n = 0; n < 2; ++n) acc[a][b][m][n] = (f32x4){0.f, 0.f, 0.f, 0.f};
    h8 At[4][2], B0[2][2], B1[2][2];
    const char* cA = (const char*)g.A + (size_t)cur.pm * tstepA; const char* cB = (const char*)g.Bt + (size_t)cur.pn * tstepB;
    PG8_STAGE(PG8_SB(0, 0), cB, voffB); PG8_STAGE(PG8_SA(0, 0), cA, voffA); PG8_STAGE(PG8_SB(0, 1), cB + hstepB, voffB); PG8_STAGE(PG8_SA(0, 1), cA + hstepA, voffA);
    if (wr == 1) PG8_BAR;
    PG8_WAIT_V(4); PG8_BAR;
    PG8_STAGE(PG8_SB(1, 0), cB + kstep, voffB); PG8_STAGE(PG8_SA(1, 0), cA + kstep, voffA); PG8_STAGE(PG8_SB(1, 1), cB + hstepB + kstep, voffB);
    PG8_WAIT_V(6); PG8_BAR;
    for (;;) {
        const bool has_next = S.next(ui + 1, nxt);
        const char* nA = has_next ? (const char*)g.A + (size_t)nxt.pm * tstepA : cA; const char* nB = has_next ? (const char*)g.Bt + (size_t)nxt.pn * tstepB : cB;
        for (int t = 0; t < nt; t += 2) {
            const bool last = (t == nt - 2);
            const char* a1 = cA + (size_t)(t + 1) * kstep;
            const char* a2 = last ? nA : cA + (size_t)(t + 2) * kstep; const char* b2 = last ? nB : cB + (size_t)(t + 2) * kstep;
            const char* a3 = a2 + kstep; const char* b3 = b2 + kstep;
            PG8_LDB(B0, 0, 0); PG8_SCHED; PG8_LDA(At, 0, 0); PG8_STAGE(PG8_SA(1, 1), a1 + hstepA, voffA);
            PG8_WAIT_L(8); PG8_BAR; PG8_WAIT_L(0); PG8_MMA(0, 0, At, B0); PG8_BAR; PG8_SCHED;
            PG8_LDB(B1, 0, 1); PG8_STAGE(PG8_SB(0, 0), b2, voffB);
            PG8_BAR; PG8_WAIT_L(0); PG8_MMA(0, 1, At, B1); PG8_BAR;
            PG8_LDA(At, 0, 1); PG8_STAGE(PG8_SA(0, 0), a2, voffA);
            PG8_BAR; PG8_WAIT_L(0); PG8_MMA(1, 0, At, B0); PG8_BAR; PG8_SCHED;
            PG8_STAGE(PG8_SB(0, 1), b2 + hstepB, voffB);
            PG8_WAIT_V(6); PG8_BAR; PG8_MMA(1, 1, At, B1); PG8_BAR;
            PG8_LDB(B0, 1, 0); PG8_SCHED; PG8_LDA(At, 1, 0); PG8_STAGE(PG8_SA(0, 1), a2 + hstepA, voffA);
            PG8_WAIT_L(8); PG8_BAR; PG8_WAIT_L(0); PG8_MMA(0, 0, At, B0); PG8_BAR; PG8_SCHED;
            PG8_LDB(B1, 1, 1); PG8_STAGE(PG8_SB(1, 0), b3, voffB);
            PG8_BAR; PG8_WAIT_L(0); PG8_MMA(0, 1, At, B1); PG8_BAR;
            PG8_LDA(At, 1, 1); PG8_STAGE(PG8_SA(1, 0), a3, voffA);
            PG8_BAR; PG8_WAIT_L(0); PG8_MMA(1, 0, At, B0); PG8_BAR; PG8_SCHED;
            PG8_STAGE(PG8_SB(1, 1), b3 + hstepB, voffB);
            PG8_WAIT_V(6); PG8_BAR; PG8_MMA(1, 1, At, B1); PG8_BAR;
        }
        E(acc, cur, wr, wc, fr, fq);
        if (!has_next) break;
#pragma unroll
        for (int a = 0; a < 2; ++a)
#pragma unroll
            for (int b = 0; b < 2; ++b)
#pragma unroll
                for (int m = 0; m < 4; ++m)
#pragma unroll
                    for (int n = 0; n < 2; ++n) acc[a][b][m][n] = (f32x4){0.f, 0.f, 0.f, 0.f};
        cur = nxt; cA = nA; cB = nB; ++ui;
    }
    PG8_WAIT_V(0);
    if (wr == 0) PG8_BAR;
    PG8_BAR;
#undef PG8_SA
#undef PG8_SB
#undef PG8_STAGE
#undef PG8_LDA
#undef PG8_LDB
#undef PG8_MMA
#undef PG8_WAIT_V
#undef PG8_WAIT_L
#undef PG8_BAR
#undef PG8_SCHED
}
}

struct EpiIn {
    static constexpr bool PERM = true;
    half_t* U; const float* lb; const float* rope;
    DI void operator()(const f32x4 (&acc)[2][2][4][2], const pg8::Unit& u, int wr, int wc, int fr, int fq) const {
        const int pn = u.pn, qq = u.pm % 17; const bool latent = qq != 0; const int t0 = (qq - 1) * 256;
#pragma unroll
        for (int ai = 0; ai < 2; ++ai)
#pragma unroll
            for (int m = 0; m < 4; ++m) {
                const int rl = ai * 128 + wr * 64 + m * 16 + fr;
                half_t* rowp = U + (size_t)(u.pm * 256 + rl) * UST + pn * 256 + wc * 32 + 8 * fq;
#pragma unroll
                for (int bj = 0; bj < 2; ++bj) {
                    f32x4 v0 = acc[ai][bj][m][0], v1 = acc[ai][bj][m][1];
                    const int cl = bj * 128 + wc * 32 + 8 * fq;
                    if (pn == 2 || pn == 3) {
                        const float* lp = lb + (pn - 2) * 256 + cl;
                        const f32x4 l0 = *(const f32x4*)lp, l1 = *(const f32x4*)(lp + 4);
#pragma unroll
                        for (int j = 0; j < 4; ++j) { v0[j] = (1.f - l0[j]) * __builtin_amdgcn_rcpf(1.f + __expf(v0[j])); v1[j] = (1.f - l1[j]) * __builtin_amdgcn_rcpf(1.f + __expf(v1[j])); }
                    } else if (pn == 4) {
#pragma unroll
                        for (int j = 0; j < 4; ++j) { v0[j] = v0[j] * __builtin_amdgcn_rcpf(1.f + __expf(-v0[j])); v1[j] = v1[j] * __builtin_amdgcn_rcpf(1.f + __expf(-v1[j])); }
                    } else if (pn >= 5 && pn <= 8) {
                        if (latent) {
                            const int t = t0 + rl; const int pos = (wc & 1) ? (t & 63) : (t >> 6);
                            const f32x4* tb = (const f32x4*)(rope + (size_t)(pos * 16 + fq * 4) * 2);
                            const f32x4 cs01 = tb[0], cs23 = tb[1];
                            const float cc[4] = {cs01[0], cs01[2], cs23[0], cs23[2]}, ss[4] = {cs01[1], cs01[3], cs23[1], cs23[3]};
#pragma unroll
                            for (int j = 0; j < 4; ++j) { const float t1 = v0[j], t2 = v1[j]; v0[j] = t1 * cc[j] - t2 * ss[j]; v1[j] = t1 * ss[j] + t2 * cc[j]; }
                        }
                        if (pn <= 6) { v0 *= QSCALE; v1 *= QSCALE; }
                    }
                    h8 o;
#pragma unroll
                    for (int j = 0; j < 4; ++j) { o[j] = (half_t)v0[j]; o[4 + j] = (half_t)v1[j]; }
                    *(h8*)(rowp + bj * 128) = o;
                }
            }
    }
};
struct EpiRes {
    static constexpr bool PERM = false;
    const float* src_lat; const float* src_ctx; float* dst_lat; float* dst_ctx; const float* gate;
    DI void operator()(const f32x4 (&acc)[2][2][4][2], const pg8::Unit& u, int wr, int wc, int fr, int fq) const {
        const int b = u.pm / 17, qq = u.pm % 17;
        const float* srcb; float* dstb; int jm;
        if (qq == 0) { const size_t off = (size_t)b * LCTX * DM; srcb = src_ctx + off; dstb = dst_ctx + off; jm = 8; }
        else { const size_t off = ((size_t)b * TLAT + (size_t)(qq - 1) * 256) * DM; srcb = src_lat + off; dstb = dst_lat + off; jm = b; }
        const float* g = gate + (size_t)jm * 6144;
        const int row0 = wr * 64 + fr, col0 = u.pn * 256 + wc * 32 + 4 * fq;
        f32x4 gv[2][2];
#pragma unroll
        for (int bj = 0; bj < 2; ++bj)
#pragma unroll
            for (int n = 0; n < 2; ++n) gv[bj][n] = *(const f32x4*)(g + col0 + bj * 128 + n * 16);
#pragma unroll
        for (int ai = 0; ai < 2; ++ai)
#pragma unroll
            for (int m = 0; m < 4; ++m) {
                const size_t ro = (size_t)(row0 + ai * 128 + m * 16) * DM + col0;
#pragma unroll
                for (int bj = 0; bj < 2; ++bj)
#pragma unroll
                    for (int n = 0; n < 2; ++n) {
                        const f32x4 old = *(const f32x4*)(srcb + ro + bj * 128 + n * 16);
                        *(f32x4*)(dstb + ro + bj * 128 + n * 16) = old + gv[bj][n] * acc[ai][bj][m][n];
                    }
            }
    }
};
struct EpiPart {
    static constexpr bool PERM = false;
    float* P;
    DI void operator()(const f32x4 (&acc)[2][2][4][2], const pg8::Unit& u, int wr, int wc, int fr, int fq) const {
        const int b = u.pm / 17, row0 = b * 256 + wr * 64 + fr, col0 = u.pn * 256 + wc * 32 + 4 * fq;
#pragma unroll
        for (int ai = 0; ai < 2; ++ai)
#pragma unroll
            for (int m = 0; m < 4; ++m)
#pragma unroll
                for (int bj = 0; bj < 2; ++bj)
#pragma unroll
                    for (int n = 0; n < 2; ++n) *(f32x4*)(P + (size_t)(row0 + ai * 128 + m * 16) * DM + col0 + bj * 128 + n * 16) = acc[ai][bj][m][n];
    }
};
struct EpiGU {
    static constexpr bool PERM = true;
    half_t* Hd;
    DI void operator()(const f32x4 (&acc)[2][2][4][2], const pg8::Unit& u, int wr, int wc, int fr, int fq) const {
#pragma unroll
        for (int ai = 0; ai < 2; ++ai)
#pragma unroll
            for (int m = 0; m < 4; ++m) {
                const int row = u.pm * 256 + ai * 128 + wr * 64 + m * 16 + fr;
                h8 o;
#pragma unroll
                for (int n = 0; n < 2; ++n)
#pragma unroll
                    for (int j = 0; j < 4; ++j) { const float gt = acc[ai][0][m][n][j], up = acc[ai][1][m][n][j]; o[4 * n + j] = (half_t)(gt * __builtin_amdgcn_rcpf(1.f + __expf(-gt)) * up); }
                *(h8*)(Hd + (size_t)row * UST + u.pn * 128 + wc * 32 + 8 * fq) = o;
            }
    }
};

DI void sincos_d(double a, float& c, float& s) {
    const double r = a - 6.283185307179586 * __builtin_rint(a * 0.15915494309189535);
    const double r2 = r * r;
    double sc = 1.0, ss = 1.0;
#pragma unroll
    for (int k = 13; k >= 1; --k) { sc = 1.0 - sc * r2 * (1.0 / (double)((2 * k - 1) * (2 * k))); ss = 1.0 - ss * r2 * (1.0 / (double)((2 * k) * (2 * k + 1))); }
    c = (float)sc; s = (float)(ss * r);
}
DI void phase_prologue(const Params& p, unsigned char* smem) {
    const int tid = ltid(), bid = blockIdx.x, nb = gridDim.x;
    float* sc = (float*)smem;
    float* red = sc + 9 * 1024;
    for (int i = tid; i < 9 * 1024; i += 512) { const int j = i >> 10, k = i & 1023; const float v = (j < 8) ? p.in[I_C][j * 1024 + k] : p.in[I_CCTX][k]; sc[i] = v / (1.f + __expf(-v)); }
    __syncthreads();
    float* MOD = (float*)(p.ws + OFF_MOD);
    for (int item = bid; item < 192; item += nb) {
        const int l = item / 48, cb = item % 48, cl = tid & 127, kq = tid >> 7, col = cb * 128 + cl;
        const float* W = p.in[I_ADAW] + (size_t)l * 1024 * 6144 + col;
        float a0 = 0, a1 = 0, a2 = 0, a3 = 0, a4 = 0, a5 = 0, a6 = 0, a7 = 0, a8 = 0;
#pragma unroll 16
        for (int k = kq * 256; k < kq * 256 + 256; ++k) {
            const float w = W[(size_t)k * 6144];
            a0 += sc[k] * w; a1 += sc[1024 + k] * w; a2 += sc[2048 + k] * w; a3 += sc[3072 + k] * w; a4 += sc[4096 + k] * w;
            a5 += sc[5120 + k] * w; a6 += sc[6144 + k] * w; a7 += sc[7168 + k] * w; a8 += sc[8192 + k] * w;
        }
        float* r = red + (kq * 128 + cl) * 9;
        r[0] = a0; r[1] = a1; r[2] = a2; r[3] = a3; r[4] = a4; r[5] = a5; r[6] = a6; r[7] = a7; r[8] = a8;
        __syncthreads();
        for (int i = tid; i < 128 * 9; i += 512) {
            const int c2 = i / 9, j = i % 9;
            const float s = red[(0 * 128 + c2) * 9 + j] + red[(1 * 128 + c2) * 9 + j] + red[(2 * 128 + c2) * 9 + j] + red[(3 * 128 + c2) * 9 + j];
            const int cc = cb * 128 + c2;
            MOD[((size_t)l * 9 + j) * 6144 + cc] = s + p.in[I_ADAB][l * 6144 + cc];
        }
        __syncthreads();
    }
    if (bid == nb - 1) {
        float* LB = (float*)(p.ws + OFF_LB);
        { const int d = tid >> 8, j = tid & 255;
          float x[4], mx = -1e30f;
#pragma unroll
          for (int i = 0; i < 4; ++i) { x[i] = p.in[I_HGLB][(d * 4 + i) * 256 + j]; mx = fmaxf(mx, x[i]); }
          float sum = 0;
#pragma unroll
          for (int i = 0; i < 4; ++i) { x[i] = expf(x[i] - mx); sum += x[i]; }
          float cum = 0;
#pragma unroll
          for (int i = 0; i < 4; ++i) { if (i > 0) cum += x[i] / sum; LB[(i * 2 + d) * 256 + j] = cum; } }
        if (tid < 4) {
            const int l = tid; float s1 = 0, s2 = 0;
            for (int i = 0; i < 64; ++i) { s1 += p.in[I_LQ1][l * 64 + i] * p.in[I_LK1][l * 64 + i]; s2 += p.in[I_LQ2][l * 64 + i] * p.in[I_LK2][l * 64 + i]; }
            const float li = 0.8f - 0.6f * expf(-0.3f * (float)l);
            float* LAM = (float*)(p.ws + OFF_LAM);
            LAM[l] = expf(s1) - expf(s2) + li; LAM[4 + l] = li;
        }
    }
    if (bid == nb - 2 || nb == 1) {
        float* RT = (float*)(p.ws + OFF_ROPE);
        for (int i = tid; i < 1024; i += 512) {
            const int pos = i >> 4, f = i & 15;
            const float invf = powf(10000.f, -(float)f / 16.f);
            const float ang = (float)pos * invf;
            float c, s; sincos_d((double)ang, c, s);
            RT[2 * i] = c; RT[2 * i + 1] = s;
        }
    }
}

DI void conv_tile(const float* src, int Nsrc, int scol0, bool rope_perm, bool zero, half_t* dst, int K, int drow0, int k0, float* tile) {
    const int tid = ltid();
#pragma unroll
    for (int i = 0; i < 8; ++i) {
        const int idx = tid + 512 * i, kk = idx >> 6, nn = idx & 63;
        int sc = nn;
        if (rope_perm) { const int grp = nn >> 3, w = nn & 7; sc = (w < 4) ? grp * 4 + w : 32 + grp * 4 + (w - 4); }
        tile[nn * 65 + kk] = zero ? 0.f : src[(size_t)(k0 + kk) * Nsrc + scol0 + sc];
    }
    __syncthreads();
    { const int nn = tid >> 3, k8 = (tid & 7) * 8; h8 o;
#pragma unroll
      for (int e = 0; e < 8; ++e) o[e] = (half_t)tile[nn * 65 + k8 + e];
      *(h8*)(dst + (size_t)(drow0 + nn) * K + k0 + k8) = o; }
    __syncthreads();
}
DI void phase_convert(const Params& p, int l, unsigned char* smem) {
    float* tile = (float*)smem;
    for (int t = blockIdx.x; t < 3328; t += gridDim.x) {
        if (t < 960) { const int nb64 = t >> 4, kb = t & 15, n0 = nb64 * 64;
            conv_tile(p.in[I_WIN] + (size_t)l * DM * INC, INC, n0, n0 >= U_DAQ && n0 < U_DAV, n0 >= INC, (half_t*)(p.ws + OFF_WIN), DM, n0, kb * 64, tile); }
        else if (t < 1216) { const int t2 = t - 960, nb64 = t2 >> 4, kb = t2 & 15;
            conv_tile(p.in[I_WOUT] + (size_t)l * DM * DM, DM, nb64 * 64, false, false, (half_t*)(p.ws + OFF_WOUT), DM, nb64 * 64, kb * 64, tile); }
        else if (t < 2624) { const int t2 = t - 1216, nb64 = t2 >> 4, kb = t2 & 15, n0 = nb64 * 64, pn = n0 >> 8, within = n0 & 255, bj = within >> 7, j0 = within & 127;
            conv_tile(p.in[bj ? I_FU : I_FG] + (size_t)l * DM * DFF, DFF, pn * 128 + j0, false, false, (half_t*)(p.ws + OFF_WGU), DM, n0, kb * 64, tile); }
        else { const int t2 = t - 2624, nb64 = t2 / 44, kb = t2 % 44;
            conv_tile(p.in[I_FD] + (size_t)l * DFF * DM, DM, nb64 * 64, false, false, (half_t*)(p.ws + OFF_WDN), DFF, nb64 * 64, kb * 64, tile); }
    }
}
DI void phase_norm(const Params& p, int l, int which) {
    const int tid_ = ltid(), wid = tid_ >> 6, lane = tid_ & 63;
    half_t* H = (half_t*)(p.ws + OFF_BC);
    const float* gn = p.in[which ? I_N2G : I_N1G] + l * DM;
    const float* MOD = (const float*)(p.ws + OFF_MOD) + (size_t)l * 9 * 6144 + which * 3072;
    for (int m0 = (blockIdx.x * 8 + wid) * 2; m0 < MROWS; m0 += gridDim.x * 16) {
        f32x4 v[2][4]; float ss[2];
#pragma unroll
        for (int r = 0; r < 2; ++r) {
            const float* xr = xsrc_row(p, which ? 1 : l, m0 + r);
#pragma unroll
            for (int i = 0; i < 4; ++i) v[r][i] = *(const f32x4*)(xr + i * 256 + lane * 4);
            if (which == 0 && l > 0 && gridDim.x == 256) {
                const int m = m0 + r, b = m / NTOK, n = m - b * NTOK;
                if (n < LCTX) {
                    const float* g2c = (const float*)(p.ws + OFF_MOD) + ((size_t)(l - 1) * 9 + 8) * 6144 + 5120;
                    const size_t ro = ((size_t)b * LCTX + n) * DM;
#pragma unroll
                    for (int i = 0; i < 4; ++i) {
                        const int c = i * 256 + lane * 4;
                        f32x4 acc = *(const f32x4*)(p.ws + OFF_PART + (ro + c) * 4);
#pragma unroll
                        for (int sl = 1; sl < 8; ++sl) acc += *(const f32x4*)(p.ws + OFF_PART + (size_t)sl * SZ_PART1 + (ro + c) * 4);
                        v[r][i] += *(const f32x4*)(g2c + c) * acc;
                        *(f32x4*)((float*)(p.ws + OFF_XC) + ro + c) = v[r][i];
                    }
                }
            }
        }
#pragma unroll
        for (int r = 0; r < 2; ++r) {
            float a = 0.f;
#pragma unroll
            for (int i = 0; i < 4; ++i) a += v[r][i][0] * v[r][i][0] + v[r][i][1] * v[r][i][1] + v[r][i][2] * v[r][i][2] + v[r][i][3] * v[r][i][3];
            ss[r] = wave_sum(a);
        }
#pragma unroll
        for (int r = 0; r < 2; ++r) {
            const int m = m0 + r, b = m / NTOK, n = m - b * NTOK;
            const float rstd = rsqrtf(ss[r] * (1.f / DM) + 1e-6f);
            const float* md = MOD + (size_t)(n < LCTX ? 8 : b) * 6144;
#pragma unroll
            for (int i = 0; i < 4; ++i) {
                const int c = i * 256 + lane * 4;
                const f32x4 g = *(const f32x4*)(gn + c), sh = *(const f32x4*)(md + c), sc = *(const f32x4*)(md + 1024 + c);
                h4 o;
#pragma unroll
                for (int j = 0; j < 4; ++j) o[j] = (half_t)(v[r][i][j] * rstd * g[j] * (1.f + sc[j]) + sh[j]);
                *(h4*)(H + (size_t)m * DM + c) = o;
            }
        }
    }
}

#define DPP_MOV_F(v, ctrl) __int_as_float(__builtin_amdgcn_mov_dpp(__float_as_int(v), (ctrl), 0xf, 0xf, true))
#define DPP_SHR_ZERO(v, ctrl) __int_as_float(__builtin_amdgcn_update_dpp(0, __float_as_int(v), (ctrl), 0xf, 0xf, false))
#define DPP_SHR_ONE(v, ctrl) __int_as_float(__builtin_amdgcn_update_dpp(0x3f800000, __float_as_int(v), (ctrl), 0xf, 0xf, false))
DI void rw_chunkprep(half_t* RW, half_t* PCB, int g, int wid, int lane, half_t* scr  ) {
    const int d = wid >> 2, h = wid & 3, c = lane & 15, q = lane >> 4;
    const int ti = d ? 15 - c : c;
    half_t* blk0 = RW + (size_t)(g * 16) * RWC + (d * 4 + h) * 320;
    half_t* myb = blk0 + (size_t)ti * RWC;
    float nkk[16], w[16], bb[16], kd[16], r[16];
#pragma unroll
    for (int s = 0; s < 2; ++s) {
        const int kq0 = 8 * s + 2 * q;
        const h8 a0 = *(const h8*)(myb + kq0 * 8), a1 = *(const h8*)(myb + kq0 * 8 + 8);
        const h8 b0 = *(const h8*)(myb + 128 + kq0 * 8), b1 = *(const h8*)(myb + 128 + kq0 * 8 + 8);
        const h8 r8 = *(const h8*)(myb + 256 + kq0 * 4);
#pragma unroll
        for (int e = 0; e < 4; ++e) {
            nkk[8 * s + e] = (float)a0[e]; w[8 * s + e] = 1.f + (float)a0[4 + e]; nkk[8 * s + 4 + e] = (float)a1[e]; w[8 * s + 4 + e] = 1.f + (float)a1[4 + e];
            bb[8 * s + e] = (float)b0[e]; kd[8 * s + e] = (float)b0[4 + e]; bb[8 * s + 4 + e] = (float)b1[e]; kd[8 * s + 4 + e] = (float)b1[4 + e];
            r[8 * s + e] = (float)r8[e]; r[8 * s + 4 + e] = (float)r8[4 + e];
        }
    }
    asm volatile("s_waitcnt vmcnt(0)" ::: "memory");
    h8 Ah[2], Rh[2], bh[2], kh[2], At8[2], Rt8[2], PC8[2];
    half_t btv[16], ktv[16];
#pragma unroll
    for (int jj = 0; jj < 16; ++jj) {
        float P = w[jj];
        P *= DPP_SHR_ONE(P, 0x111); P *= DPP_SHR_ONE(P, 0x112); P *= DPP_SHR_ONE(P, 0x114); P *= DPP_SHR_ONE(P, 0x118);
        const float Pm1 = DPP_SHR_ONE(P, 0x111);
        const float PC = DPP_MOV_F(P, 0x15F), P7 = DPP_MOV_F(P, 0x157);
        const float rP = __builtin_amdgcn_rcpf(P), rP7 = __builtin_amdgcn_rcpf(P7);
        const float At = nkk[jj] * Pm1, Rt = r[jj] * P;
        At8[jj >> 3][jj & 7] = (half_t)At; Rt8[jj >> 3][jj & 7] = (half_t)Rt; PC8[jj >> 3][jj & 7] = (half_t)PC;
        btv[jj] = (half_t)(bb[jj] * PC * rP); ktv[jj] = (half_t)(kd[jj] * PC * rP);
        Ah[jj >> 3][jj & 7] = (half_t)(At * rP7); Rh[jj >> 3][jj & 7] = (half_t)(Rt * rP7);
        bh[jj >> 3][jj & 7] = (half_t)(bb[jj] * P7 * rP); kh[jj >> 3][jj & 7] = (half_t)(kd[jj] * P7 * rP);
    }
    f32x4 ab = {0.f, 0.f, 0.f, 0.f}, ak = ab, rb = ab, rk = ab;
#pragma unroll
    for (int s = 0; s < 2; ++s) {
        ab = __builtin_amdgcn_mfma_f32_16x16x32_f16(Ah[s], bh[s], ab, 0, 0, 0); ak = __builtin_amdgcn_mfma_f32_16x16x32_f16(Ah[s], kh[s], ak, 0, 0, 0);
        rb = __builtin_amdgcn_mfma_f32_16x16x32_f16(Rh[s], bh[s], rb, 0, 0, 0); rk = __builtin_amdgcn_mfma_f32_16x16x32_f16(Rh[s], kh[s], rk, 0, 0, 0);
    }
    asm volatile("s_nop 15\n\ts_nop 15" : "+v"(ab), "+v"(ak), "+v"(rb), "+v"(rk));
#pragma unroll
    for (int s = 0; s < 2; ++s) {
        *(h8*)(myb + 32 * s + 8 * q) = At8[s]; *(h8*)(myb + 64 + 32 * s + 8 * q) = Rt8[s];
        if (c == 15) *(h8*)(PCB + (((size_t)g * 2 + d) * 4 + h) * 64 + 32 * s + 8 * q) = PC8[s];
#pragma unroll
        for (int j = 0; j < 8; ++j) {
            const int cbk = 8 * s + 2 * q + (j >> 2), kk = j & 3;
            half_t* ob = blk0 + (size_t)(d ? 15 - cbk : cbk) * RWC;
            ob[128 + kk * 16 + c] = btv[8 * s + j]; ob[192 + kk * 16 + c] = ktv[8 * s + j];
        }
    }
#pragma unroll
    for (int j = 0; j < 4; ++j) {
        const int cr = 4 * q + j;
        half_t* ob = blk0 + (size_t)(d ? 15 - cr : cr) * RWC + 256 + c;
        scr[cr * 16 + c] = (half_t)(c < cr ? ab[j] : 0.f);
        ob[16] = (half_t)(c < cr ? ak[j] : 0.f); ob[32] = (half_t)(c <= cr ? rb[j] : 0.f); ob[48] = (half_t)(c <= cr ? rk[j] : 0.f);
    }
    __builtin_amdgcn_fence(__ATOMIC_RELEASE, "wavefront"); __builtin_amdgcn_wave_barrier(); __builtin_amdgcn_fence(__ATOMIC_ACQUIRE, "wavefront");
    {
        const h8 n0 = *(const h8*)(scr + c * 16), n1 = *(const h8*)(scr + c * 16 + 8);
        float t[4];
#pragma unroll
        for (int mm = 0; mm < 4; ++mm) t[mm] = (c == 4 * q + mm) ? 1.f : 0.f;
#define CP_STEP(sN, coef) do { const float cf_ = (float)(coef); _Pragma("unroll") for (int mm = 0; mm < 4; ++mm) t[mm] = fmaf(cf_, DPP_MOV_F(t[mm], 0x150 + (sN)), t[mm]); } while (0)
        CP_STEP(0, n0[0]); CP_STEP(1, n0[1]); CP_STEP(2, n0[2]); CP_STEP(3, n0[3]); CP_STEP(4, n0[4]); CP_STEP(5, n0[5]); CP_STEP(6, n0[6]); CP_STEP(7, n0[7]);
        CP_STEP(8, n1[0]); CP_STEP(9, n1[1]); CP_STEP(10, n1[2]); CP_STEP(11, n1[3]); CP_STEP(12, n1[4]); CP_STEP(13, n1[5]); CP_STEP(14, n1[6]);
#undef CP_STEP
        h4 t4;
#pragma unroll
        for (int mm = 0; mm < 4; ++mm) t4[mm] = (half_t)t[mm];
        *(h4*)(myb + 256 + 4 * q) = t4;
        __builtin_amdgcn_wave_barrier();
    }
}

DI void phase_rwprep(const Params& p, int l, unsigned char* smem) {
    const int tid = ltid(), wid = tid >> 6, lane = tid & 63;
    h2* Wp = (h2*)smem;
    half_t* svh = (half_t*)(smem + 98304) + wid * 384;
    for (int i = tid; i < 96 * 256; i += 512) {
        const int jp = i >> 8, c = i & 255; const float* src;
        if (jp < 32) { const int d = jp >> 4, j = (jp & 15) * 2; src = p.in[I_W2] + (((size_t)d * DEPTH + l) * 32 + j) * 256 + c; }
        else if (jp < 64) { const int d = (jp - 32) >> 4, j = (jp & 15) * 2; src = p.in[I_A2] + (((size_t)d * DEPTH + l) * 32 + j) * 256 + c; }
        else src = p.in[I_G2] + ((size_t)l * 64 + (jp - 64) * 2) * 256 + c;
        h2 v; v[0] = (half_t)src[0]; v[1] = (half_t)src[256];
        Wp[i] = v;
    }
    __syncthreads();
    const int c4 = lane * 4;
    float mp[3][4], mn[3][4], mpl[3], mnl[3], kkc[4], kac[4], rkc[4], w0c[2][4], a0c[2][4];
    const float* MUP = p.in[I_MUP] + l * 960; const float* MUN = p.in[I_MUN] + l * 960;
#pragma unroll
    for (int s = 0; s < 3; ++s) {
#pragma unroll
        for (int i = 0; i < 4; ++i) { mp[s][i] = MUP[s * 256 + c4 + i]; mn[s][i] = MUN[s * 256 + c4 + i]; }
        mpl[s] = MUP[768 + lane + 64 * s]; mnl[s] = MUN[768 + lane + 64 * s];
    }
#pragma unroll
    for (int i = 0; i < 4; ++i) {
        kkc[i] = p.in[I_KK][l * 256 + c4 + i]; kac[i] = p.in[I_KA][l * 256 + c4 + i]; rkc[i] = p.in[I_RK][l * 256 + c4 + i];
#pragma unroll
        for (int d = 0; d < 2; ++d) { w0c[d][i] = p.in[I_W0][(d * DEPTH + l) * 256 + c4 + i]; a0c[d][i] = p.in[I_A0][(d * DEPTH + l) * 256 + c4 + i]; }
    }
    const half_t* U = (const half_t*)(p.ws + OFF_U);
    half_t* RW = (half_t*)(p.ws + OFF_BC);
    float* CB = (float*)(p.ws + OFF_CB);
    const h4 hz = {(half_t)0, (half_t)0, (half_t)0, (half_t)0};
    h4 pz[3][4]; half_t pl[3][4];
#define RP_LOAD(gg) do { const int m0_ = (gg) * 16 + wid * 2, n0_ = m0_ % NTOK; const bool hp_ = (n0_ != 0 && n0_ != LCTX), hn_ = (n0_ + 1 != LCTX - 1 && n0_ + 1 != NTOK - 1); \
        const half_t* u0_ = U + (size_t)m0_ * UST + U_RW; \
        _Pragma("unroll") for (int s = 0; s < 3; ++s) { const int col = 768 + lane + 64 * s; \
            pz[s][0] = hp_ ? *(const h4*)(u0_ - UST + s * 256 + c4) : hz; pz[s][1] = *(const h4*)(u0_ + s * 256 + c4); pz[s][2] = *(const h4*)(u0_ + UST + s * 256 + c4); pz[s][3] = hn_ ? *(const h4*)(u0_ + 2 * UST + s * 256 + c4) : hz; \
            pl[s][0] = hp_ ? u0_[col - UST] : (half_t)0; pl[s][1] = u0_[col]; pl[s][2] = u0_[col + UST]; pl[s][3] = hn_ ? u0_[col + 2 * UST] : (half_t)0; } } while (0)
    if ((int)blockIdx.x < MROWS / 16) RP_LOAD((int)blockIdx.x);
    for (int g = blockIdx.x; g < MROWS / 16; g += gridDim.x) {
        const int m0 = g * 16 + wid * 2;
        float val[2][3][4]; float zl[3][4];
#pragma unroll
        for (int s = 0; s < 3; ++s) {
#pragma unroll
            for (int i = 0; i < 4; ++i) {
                const float xa = (float)pz[s][0][i], xb = (float)pz[s][1][i], xc = (float)pz[s][2][i], xd = (float)pz[s][3][i];
                val[0][s][i] = xb + mp[s][i] * (xa - xb) + mn[s][i] * (xc - xb);
                val[1][s][i] = xc + mp[s][i] * (xb - xc) + mn[s][i] * (xd - xc);
            }
#pragma unroll
            for (int r = 0; r < 4; ++r) zl[s][r] = (float)pl[s][r];
        }
        if (g + (int)gridDim.x < MROWS / 16) RP_LOAD(g + (int)gridDim.x);
#pragma unroll
        for (int s = 0; s < 3; ++s) {
            const float xa = zl[s][0], xb = zl[s][1], xc = zl[s][2], xd = zl[s][3];
            float z0 = xb + mpl[s] * (xa - xb) + mnl[s] * (xc - xb), z1 = xc + mpl[s] * (xb - xc) + mnl[s] * (xd - xc);
            if (s == 0) { z0 = 1.f - 2.f * __builtin_amdgcn_rcpf(1.f + __expf(2.f * z0)); z1 = 1.f - 2.f * __builtin_amdgcn_rcpf(1.f + __expf(2.f * z1)); }
            else if (s == 2) { z0 = sigmoidf_(z0); z1 = sigmoidf_(z1); }
            svh[lane + 64 * s] = (half_t)z0; svh[192 + lane + 64 * s] = (half_t)z1;
        }
        __builtin_amdgcn_fence(__ATOMIC_RELEASE, "wavefront"); __builtin_amdgcn_wave_barrier(); __builtin_amdgcn_fence(__ATOMIC_ACQUIRE, "wavefront");
        float wl[2][2][4], al[2][2][4], gt[2][4];
#pragma unroll
        for (int tt = 0; tt < 2; ++tt)
#pragma unroll
            for (int i = 0; i < 4; ++i) { wl[tt][0][i] = w0c[0][i]; wl[tt][1][i] = w0c[1][i]; al[tt][0][i] = a0c[0][i]; al[tt][1][i] = a0c[1][i]; gt[tt][i] = 0.f; }
        const h2* sv2 = (const h2*)svh;
#pragma unroll 4
        for (int jp = 0; jp < 16; ++jp) {
#pragma unroll
            for (int d = 0; d < 2; ++d) {
                const h8 w = *(const h8*)(Wp + (d * 16 + jp) * 256 + c4), a = *(const h8*)(Wp + (32 + d * 16 + jp) * 256 + c4);
#pragma unroll
                for (int tt = 0; tt < 2; ++tt) {
                    const h2 s1 = sv2[tt * 96 + d * 16 + jp], s2 = sv2[tt * 96 + 32 + d * 16 + jp];
                    wl[tt][d][0] = __builtin_amdgcn_fdot2(__builtin_shufflevector(w, w, 0, 1), s1, wl[tt][d][0], false);
                    wl[tt][d][1] = __builtin_amdgcn_fdot2(__builtin_shufflevector(w, w, 2, 3), s1, wl[tt][d][1], false);
                    wl[tt][d][2] = __builtin_amdgcn_fdot2(__builtin_shufflevector(w, w, 4, 5), s1, wl[tt][d][2], false);
                    wl[tt][d][3] = __builtin_amdgcn_fdot2(__builtin_shufflevector(w, w, 6, 7), s1, wl[tt][d][3], false);
                    al[tt][d][0] = __builtin_amdgcn_fdot2(__builtin_shufflevector(a, a, 0, 1), s2, al[tt][d][0], false);
                    al[tt][d][1] = __builtin_amdgcn_fdot2(__builtin_shufflevector(a, a, 2, 3), s2, al[tt][d][1], false);
                    al[tt][d][2] = __builtin_amdgcn_fdot2(__builtin_shufflevector(a, a, 4, 5), s2, al[tt][d][2], false);
                    al[tt][d][3] = __builtin_amdgcn_fdot2(__builtin_shufflevector(a, a, 6, 7), s2, al[tt][d][3], false);
                }
            }
        }
#pragma unroll 4
        for (int jp = 0; jp < 32; ++jp) {
            const h8 g = *(const h8*)(Wp + (64 + jp) * 256 + c4);
#pragma unroll
            for (int tt = 0; tt < 2; ++tt) {
                const h2 sg = sv2[tt * 96 + 64 + jp];
                gt[tt][0] = __builtin_amdgcn_fdot2(__builtin_shufflevector(g, g, 0, 1), sg, gt[tt][0], false);
                gt[tt][1] = __builtin_amdgcn_fdot2(__builtin_shufflevector(g, g, 2, 3), sg, gt[tt][1], false);
                gt[tt][2] = __builtin_amdgcn_fdot2(__builtin_shufflevector(g, g, 4, 5), sg, gt[tt][2], false);
                gt[tt][3] = __builtin_amdgcn_fdot2(__builtin_shufflevector(g, g, 6, 7), sg, gt[tt][3], false);
            }
        }
        __builtin_amdgcn_wave_barrier();
        const int hd = lane >> 4, kq_ = lane & 15;
#pragma unroll
        for (int tt = 0; tt < 2; ++tt) {
            float kkv[4], ssq = 0.f;
#pragma unroll
            for (int i = 0; i < 4; ++i) { kkv[i] = val[tt][1][i] * kkc[i]; ssq += kkv[i] * kkv[i]; }
            ssq = row16_sum(ssq);
            const float kn = rsqrtf(fmaxf(ssq, 1e-24f));
            half_t* rp = RW + (size_t)(m0 + tt) * RWC;
            h4 o_r, o_v, o_nkk, o_g;
#pragma unroll
            for (int i = 0; i < 4; ++i) { kkv[i] *= kn; o_r[i] = (half_t)val[tt][0][i]; o_v[i] = (half_t)val[tt][2][i]; o_nkk[i] = (half_t)(-kkv[i]); o_g[i] = (half_t)gt[tt][i]; }
            *(h4*)(rp + R_V + c4) = o_v; *(h4*)(rp + R_GATE + c4) = o_g;
            float bon = 0.f;
#pragma unroll
            for (int d = 0; d < 2; ++d) {
                h4 o_w, o_kd, o_bb;
#pragma unroll
                for (int i = 0; i < 4; ++i) {
                    const float e = 0.6065306597126334f * sigmoidf_(wl[tt][d][i]);
                    const float omw = 1.f - __expf(-e);
                    const float a = sigmoidf_(al[tt][d][i]);
                    const float kd = val[tt][1][i] * (1.f + (a - 1.f) * kac[i]);
                    o_w[i] = (half_t)(-omw); o_kd[i] = (half_t)kd; o_bb[i] = (half_t)(kkv[i] * a);
                    bon += val[tt][0][i] * kd * rkc[i];
                }
                half_t* bp = rp + (d * 4 + hd) * 320;
                const h8 pa = __builtin_shufflevector(o_nkk, o_w, 0, 1, 2, 3, 4, 5, 6, 7), pb = __builtin_shufflevector(o_bb, o_kd, 0, 1, 2, 3, 4, 5, 6, 7);
                *(h8*)(bp + kq_ * 8) = pa; *(h8*)(bp + 128 + kq_ * 8) = pb; *(h4*)(bp + 256 + kq_ * 4) = o_r;
            }
            bon = row16_sum(bon);
            if ((lane & 15) == 0) CB[(size_t)(m0 + tt) * 4 + (lane >> 4)] = bon;
        }
    }
    __syncthreads();
    {
        const int tid2 = ltid();
#pragma unroll 1
        for (int g = blockIdx.x; g < MROWS / 16; g += gridDim.x) rw_chunkprep((half_t*)(p.ws + OFF_BC), (half_t*)(p.ws + OFF_PCB), g, tid2 >> 6, tid2 & 63, (half_t*)(smem + 98304) + (tid2 >> 6) * 384);
    }
}

constexpr int SC_CH = 32, SC_RWSTEP = 672, SC_HGOFF = SC_CH * SC_RWSTEP, SC_HGSTEP = 288, SC_PCOFF = SC_HGOFF + SC_CH * SC_HGSTEP, SC_NPIECE = 1936, SC_BUF = 2240 * 16, SC_OPS = 3 * SC_BUF, SC_JOB = 5760;
DI void phase_scan(const Params& p, int l, unsigned char* smem) {
    const int tid = ltid(), wid = tid >> 6, lane = tid & 63, grp = lane >> 4, kq = lane & 15;
    half_t* U = (half_t*)(p.ws + OFF_U);
    const half_t* RW = (const half_t*)(p.ws + OFF_BC);
    for (int job = blockIdx.x; job < 256; job += gridDim.x) {
        const int s = (gridDim.x == 256) ? (job & 7) + 8 * (job >> 5) : job >> 2, quarter = (gridDim.x == 256) ? (job >> 3) & 3 : job & 3, b = s >> 3, h = (s >> 1) & 3, d = s & 1, sgn = d ? -1 : 1;
        const size_t rowb = (size_t)b * NTOK;
        const half_t* PCB = (const half_t*)(p.ws + OFF_PCB);
        const int lrank = (wid == 1) ? 0 : (wid == 3) ? 1 : wid - 3;
        const bool is_ld = (wid == 1 || wid == 3 || wid >= 5);
        const int lt = lrank * 64 + lane;
        unsigned l_base[7]; int l_strb[7];
#pragma unroll
        for (int j = 0; j < 7; ++j) {
            const int pc = lt + 320 * j; size_t off; int i, strb;
            if (pc < 1344) { i = pc / 42; const int w = pc - i * 42; strb = RWC * 2;
                off = OFF_BC + ((w < 40) ? rowb * RWC + (d * 4 + h) * 320 + w * 8 : rowb * RWC + R_V + h * 64 + quarter * 16 + (w - 40) * 8) * 2; }
            else if (pc < 1920) { const int p2 = pc - 1344; i = p2 / 18; const int w = p2 - i * 18; strb = UST * 2;
                off = OFF_U + ((w < 8) ? rowb * UST + U_HGKF + d * 256 + h * 64 + w * 8 : (w < 16) ? rowb * UST + U_HGQ + h * 64 + (w - 8) * 8 : rowb * UST + U_HGI + h * 64 + quarter * 16 + (w - 16) * 8) * 2; }
            else { const int pp = (pc < SC_NPIECE) ? pc - 1920 : 0, j2 = pp >> 3, part = pp & 7;
                i = d ? 16 * j2 + 15 : 16 * j2; strb = 64;
                off = OFF_PCB + ((rowb >> 4) * 512 + (d * 4 + h) * 64 + part * 8) * 2; }
            l_base[j] = (unsigned)((long long)off + (long long)(sgn * i) * strb); l_strb[j] = strb;
        }
        auto chunk_tok0 = [&](int ch) -> int {
            const int seg = ch >= LCTX / SC_CH, t = seg ? (ch - LCTX / SC_CH) * SC_CH : ch * SC_CH;
            const int tok0 = d ? (seg ? NTOK - 1 : LCTX - 1) : (seg ? LCTX : 0);
            return tok0 + sgn * t; };
        LAS unsigned char* lds0 = (LAS unsigned char*)smem;
#define SC_DMA(ch, bi) do { const int t0_ = chunk_tok0(ch); _Pragma("unroll") for (int j = 0; j < 7; ++j) \
            __builtin_amdgcn_global_load_lds((const unsigned*)(p.ws + (size_t)(l_base[j] + (unsigned)(t0_ * l_strb[j]))), (LAS unsigned*)(lds0 + (bi) * SC_BUF + (lrank * 64 + 320 * j) * 16), 16, 0, 0); } while (0)
        constexpr int NCH = NTOK / SC_CH;
        if (is_ld) { SC_DMA(0, 0); SC_DMA(1, 1); }
        f32x4 St[4];
#pragma unroll
        for (int kt = 0; kt < 4; ++kt) St[kt] = (f32x4){0.f, 0.f, 0.f, 0.f};
        const int rr = ((wid & 3) * 4 + grp);
        half_t* obase = (wid < 4) ? U + rowb * UST + U_YF + d * 256 + h * 64 + quarter * 16 + rr : U + rowb * UST + U_OF + d * 256 + h * 64 + quarter * 16 + rr;
        f32x4 Sh[4];
#pragma unroll
        for (int kt = 0; kt < 4; ++kt) Sh[kt] = (f32x4){0.f, 0.f, 0.f, 0.f};
        int bcur = 0;
#pragma unroll 1
        for (int ch = 0; ch <= NCH; ++ch) {
            if (is_ld) { if (ch + 1 >= NCH) asm volatile("s_waitcnt vmcnt(0)" ::: "memory"); else asm volatile("s_waitcnt vmcnt(7)" ::: "memory"); }
            asm volatile("s_waitcnt lgkmcnt(0)" ::: "memory"); __builtin_amdgcn_s_barrier(); asm volatile("" ::: "memory");
            const int bnxt2 = (bcur == 0) ? 2 : bcur - 1;
            if (is_ld && ch + 2 < NCH) SC_DMA(ch + 2, bnxt2);
            const unsigned char* bufp = smem + bcur * SC_BUF;
            bcur = (bcur == 2) ? 0 : bcur + 1;
            const int tokc = chunk_tok0(ch < NCH ? ch : NCH - 1);
            {
                if (wid == 0 && ch < NCH) {
                    const int x = lane & 15, q = lane >> 4;
#pragma unroll 1
                    for (int j2 = 0; j2 < 2; ++j2) {
                        const unsigned char* cb = bufp + (16 * j2) * SC_RWSTEP;
                        const unsigned char* mb = cb + x * SC_RWSTEP;
                        const half_t* pcb = (const half_t*)(bufp + SC_PCOFF + j2 * 128);
                        h8 atf[2], rtf[2], bkf[4]; h4 pcf[4];
#pragma unroll
                        for (int sI = 0; sI < 2; ++sI) {
                            const h4 lo = *(const h4*)(mb + (32 * sI + 4 * q) * 2), hi = *(const h4*)(mb + (32 * sI + 16 + 4 * q) * 2);
                            atf[sI] = __builtin_shufflevector(lo, hi, 0, 1, 2, 3, 4, 5, 6, 7);
                            const h4 lo2 = *(const h4*)(mb + (64 + 32 * sI + 4 * q) * 2), hi2 = *(const h4*)(mb + (64 + 32 * sI + 16 + 4 * q) * 2);
                            rtf[sI] = __builtin_shufflevector(lo2, hi2, 0, 1, 2, 3, 4, 5, 6, 7);
                        }
                        h4 Vf;
#pragma unroll
                        for (int j = 0; j < 4; ++j) Vf[j] = *(const half_t*)(cb + (4 * q + j) * SC_RWSTEP + 640 + x * 2);
                        const h4 akf = *(const h4*)(mb + (272 + 4 * q) * 2);
                        const h4 tfr = *(const h4*)(mb + (256 + 4 * q) * 2);
                        const h4 arb = *(const h4*)(mb + (288 + 4 * q) * 2), ark = *(const h4*)(mb + (304 + 4 * q) * 2);
#pragma unroll
                        for (int kt = 0; kt < 4; ++kt) {
                            const unsigned char* kb2 = cb + (4 * kt + (x >> 2)) * SC_RWSTEP;
                            const h4 bt = *(const h4*)(kb2 + (128 + (x & 3) * 16 + 4 * q) * 2), ktt = *(const h4*)(kb2 + (192 + (x & 3) * 16 + 4 * q) * 2);
                            bkf[kt] = __builtin_shufflevector(bt, ktt, 0, 1, 2, 3, 4, 5, 6, 7);
                            pcf[kt] = *(const h4*)(pcb + 16 * kt + 4 * q);
                        }
                        h8 Sf[2];
#pragma unroll
                        for (int sI = 0; sI < 2; ++sI)
#pragma unroll
                            for (int j = 0; j < 4; ++j) { Sf[sI][j] = (half_t)St[2 * sI][j]; Sf[sI][4 + j] = (half_t)St[2 * sI + 1][j]; }
                        f32x4 XT = {0.f, 0.f, 0.f, 0.f};
#pragma unroll
                        for (int sI = 0; sI < 2; ++sI) XT = __builtin_amdgcn_mfma_f32_16x16x32_f16(atf[sI], Sf[sI], XT, 0, 0, 0);
                        XT = __builtin_amdgcn_mfma_f32_16x16x16f16(akf, Vf, XT, 0, 0, 0);
#pragma unroll
                        for (int kt = 0; kt < 4; ++kt)
#pragma unroll
                            for (int j = 0; j < 4; ++j) St[kt][j] *= (float)pcf[kt][j];
                        f32x4 Yv = {0.f, 0.f, 0.f, 0.f};
#pragma unroll
                        for (int sI = 0; sI < 2; ++sI) Yv = __builtin_amdgcn_mfma_f32_16x16x32_f16(rtf[sI], Sf[sI], Yv, 0, 0, 0);
                        asm volatile("s_nop 15\n\ts_nop 15" : "+v"(XT));
                        h8 UV;
                        { h4 xh;
#pragma unroll
                          for (int j = 0; j < 4; ++j) xh[j] = (half_t)XT[j];
                          f32x4 Uc = {0.f, 0.f, 0.f, 0.f};
                          Uc = __builtin_amdgcn_mfma_f32_16x16x16f16(tfr, xh, Uc, 0, 0, 0);
                          asm volatile("s_nop 15\n\ts_nop 15" : "+v"(Uc));
#pragma unroll
                          for (int j = 0; j < 4; ++j) { UV[j] = (half_t)Uc[j]; UV[4 + j] = Vf[j]; } }
                        Yv = __builtin_amdgcn_mfma_f32_16x16x32_f16(__builtin_shufflevector(arb, ark, 0, 1, 2, 3, 4, 5, 6, 7), UV, Yv, 0, 0, 0);
                        asm volatile("s_nop 15\n\ts_nop 15" : "+v"(Yv));
                        { half_t* yb = U + rowb * UST + U_YF + d * 256 + h * 64 + quarter * 16 + x;
#pragma unroll
                          for (int j = 0; j < 4; ++j) yb[(ptrdiff_t)(tokc + sgn * (16 * j2 + 4 * q + j)) * UST] = (half_t)Yv[j]; }
#pragma unroll
                        for (int kt = 0; kt < 4; ++kt) St[kt] = __builtin_amdgcn_mfma_f32_16x16x32_f16(bkf[kt], UV, St[kt], 0, 0, 0);
                        asm volatile("s_nop 15\n\ts_nop 15" : "+v"(St[0]), "+v"(St[1]), "+v"(St[2]), "+v"(St[3]));
                    }
                }
                if ((wid == 3 || wid >= 5) && ch < NCH) {
                    const int pw = (wid == 3) ? 3 : wid - 5, j2 = pw >> 1, sI = pw & 1, c = lane & 15, q = lane >> 4;
                    const unsigned char* hb = bufp + SC_HGOFF + (16 * j2 + c) * SC_HGSTEP;
                    unsigned char* ob = smem + SC_OPS + ((ch & 1) * 2 + j2) * SC_JOB;
                    f32x4 aq = {0.f, 0.f, 0.f, 0.f};
                    {
                        const h8 kf8 = *(const h8*)(hb + (32 * sI + 8 * q) * 2), q8 = *(const h8*)(hb + 128 + (32 * sI + 8 * q) * 2);
                        h8 qt8, pc8;
#pragma unroll
                        for (int j = 0; j < 8; ++j) {
                            const float kfv = (float)kf8[j], qv = (float)q8[j];
                            float bsum = fmaxf(__builtin_amdgcn_logf(1.f - kfv) * 0.6931471805599453f, -80.f);
                            bsum += DPP_SHR_ZERO(bsum, 0x111); bsum += DPP_SHR_ZERO(bsum, 0x112); bsum += DPP_SHR_ZERO(bsum, 0x114); bsum += DPP_SHR_ZERO(bsum, 0x118);
                            const float bC = DPP_MOV_F(bsum, 0x15F), bm = DPP_MOV_F(bsum, 0x157);
                            float eb = __expf(bsum);
                            asm volatile("s_nop 1" : "+v"(eb));
                            qt8[j] = (half_t)(qv * eb); pc8[j] = (half_t)DPP_MOV_F(eb, 0x15F);
                            *(half_t*)(ob + 2048 + ((32 * sI + 8 * q + j) * 16 + c) * 2) = (half_t)(kfv * __expf(bC - bsum));
                            const float em = __expf(fminf(fmaxf(bsum - bm, -60.f), 60.f));
                            const float qh = qv * em, kh = kfv * __builtin_amdgcn_rcpf(em);
                            aq = __builtin_amdgcn_mfma_f32_16x16x4f32(qh, kh, aq, 0, 0, 0);
                        }
                        *(h8*)(ob + (c * 64 + 32 * sI + 8 * q) * 2) = qt8;
                        if (c == 15) *(h8*)(ob + 4608 + (32 * sI + 8 * q) * 2) = pc8;
                    }
                    asm volatile("s_nop 15\n\ts_nop 15" : "+v"(aq));
#pragma unroll
                    for (int j = 0; j < 4; ++j) { const int cr = 4 * q + j; *(half_t*)(ob + (sI ? 5248 : 4096) + (cr * 16 + c) * 2) = (half_t)(c <= cr ? aq[j] : 0.f); }
                    if (sI == 0) *(h4*)(ob + 4736 + (lane >> 2) * 32 + (lane & 3) * 8) = *(const h4*)(bufp + SC_HGOFF + (16 * j2 + (lane >> 2)) * SC_HGSTEP + 256 + (lane & 3) * 8);
                }
                if (wid == 2 && ch >= 1) {
                    const int x = lane & 15, q = lane >> 4, tokp = chunk_tok0(ch - 1);
#pragma unroll 1
                    for (int j2 = 0; j2 < 2; ++j2) {
                        const unsigned char* ob = smem + SC_OPS + (((ch - 1) & 1) * 2 + j2) * SC_JOB;
                        h8 Sf[2];
#pragma unroll
                        for (int sI = 0; sI < 2; ++sI)
#pragma unroll
                            for (int j = 0; j < 4; ++j) { Sf[sI][j] = (half_t)Sh[2 * sI][j]; Sf[sI][4 + j] = (half_t)Sh[2 * sI + 1][j]; }
                        f32x4 Yv = {0.f, 0.f, 0.f, 0.f};
#pragma unroll
                        for (int sI = 0; sI < 2; ++sI) {
                            const h4 lo = *(const h4*)(ob + (x * 64 + 32 * sI + 4 * q) * 2), hi = *(const h4*)(ob + (x * 64 + 32 * sI + 16 + 4 * q) * 2);
                            Yv = __builtin_amdgcn_mfma_f32_16x16x32_f16(__builtin_shufflevector(lo, hi, 0, 1, 2, 3, 4, 5, 6, 7), Sf[sI], Yv, 0, 0, 0);
                        }
                        h4 Vf;
#pragma unroll
                        for (int j = 0; j < 4; ++j) Vf[j] = *(const half_t*)(ob + 4736 + ((4 * q + j) * 16 + x) * 2);
                        { const h4 aqf = *(const h4*)(ob + 4096 + (x * 16 + 4 * q) * 2), aqg = *(const h4*)(ob + 5248 + (x * 16 + 4 * q) * 2);
                          Yv = __builtin_amdgcn_mfma_f32_16x16x16f16(aqf, Vf, Yv, 0, 0, 0); Yv = __builtin_amdgcn_mfma_f32_16x16x16f16(aqg, Vf, Yv, 0, 0, 0); }
                        asm volatile("s_nop 15\n\ts_nop 15" : "+v"(Yv));
                        { half_t* yb = U + rowb * UST + U_OF + d * 256 + h * 64 + quarter * 16 + x;
#pragma unroll
                          for (int j = 0; j < 4; ++j) yb[(ptrdiff_t)(tokp + sgn * (16 * j2 + 4 * q + j)) * UST] = (half_t)Yv[j]; }
#pragma unroll
                        for (int kt = 0; kt < 4; ++kt) {
                            const h4 kt4 = *(const h4*)(ob + 2048 + ((16 * kt + x) * 16 + 4 * q) * 2), pc = *(const h4*)(ob + 4608 + (16 * kt + 4 * q) * 2);
                            f32x4 sc = Sh[kt];
#pragma unroll
                            for (int j = 0; j < 4; ++j) sc[j] *= (float)pc[j];
                            Sh[kt] = __builtin_amdgcn_mfma_f32_16x16x16f16(kt4, Vf, sc, 0, 0, 0);
                        }
                        asm volatile("s_nop 15\n\ts_nop 15" : "+v"(Sh[0]), "+v"(Sh[1]), "+v"(Sh[2]), "+v"(Sh[3]));
                    }
                }
            }
        }
        __syncthreads();
#undef SC_DMA
    }
}

DI void attn_item(const Params& p, int l, int item, unsigned char* smem, float lam, float lam_init) {
    const int tid = ltid(), wid = tid >> 6, lane = tid & 63;
    int b, h, n0, nkt;
    if (item < 512) { b = item >> 6; h = (item >> 4) & 3; n0 = LCTX + (item & 15) * 256; nkt = NTOK / 64; }
    else { const int i2 = item - 512; b = i2 >> 2; h = i2 & 3; n0 = 0; nkt = LCTX / 64; }
    half_t* U = (half_t*)(p.ws + OFF_U);
    const size_t rowb = (size_t)b * NTOK;
    const int q = lane & 31, hh = lane >> 5, qq = (lane & 15) >> 2, pp = lane & 3, blk = (lane >> 4) & 1;
    half_t* qrow = U + (rowb + n0 + wid * 32 + q) * UST + U_DAQ + h * 128;
    const int kkey = tid >> 3, kch = tid & 7, vkey = tid >> 4, vch = tid & 15;
    h2 o0p[32];
    f32x16 O[4];
    float inv = 0.f;
    for (int mp = 0; mp < 2; ++mp) {
        h8 qf[4];
#pragma unroll
        for (int s = 0; s < 4; ++s) qf[s] = *(const h8*)(qrow + mp * 64 + 16 * s + 8 * hh);
#pragma unroll
        for (int t = 0; t < 4; ++t)
#pragma unroll
            for (int i = 0; i < 16; ++i) O[t][i] = 0.f;
        float l_part = 0.f;
        f32x16 NEGM;
#pragma unroll
        for (int i = 0; i < 16; ++i) NEGM[i] = 0.f;
        const half_t* kg = U + (rowb + kkey) * UST + U_DAK + h * 128 + mp * 64 + kch * 8;
        const half_t* vg = U + (rowb + vkey) * UST + U_DAV + h * 128 + vch * 8;
        h8 kreg = *(const h8*)kg, vreg0 = *(const h8*)vg, vreg1 = *(const h8*)(vg + (size_t)32 * UST);
        for (int kt = 0; kt < nkt; ++kt) {
            unsigned char* Kc = smem + (kt & 1) * 9216; unsigned char* Vc = smem + 18432 + (kt & 1) * 18432;
            *(h8*)(Kc + kkey * 144 + kch * 16) = kreg;
            *(h8*)(Vc + vkey * 288 + vch * 16) = vreg0; *(h8*)(Vc + (vkey + 32) * 288 + vch * 16) = vreg1;
            __syncthreads();
            if (kt + 1 < nkt) { const size_t adv = (size_t)(kt + 1) * 64 * UST; kreg = *(const h8*)(kg + adv); vreg0 = *(const h8*)(vg + adv); vreg1 = *(const h8*)(vg + adv + (size_t)32 * UST); }
            f32x16 S0 = NEGM, S1 = NEGM;
#pragma unroll
            for (int s = 0; s < 4; ++s) {
                const h8 k0 = *(const h8*)(Kc + q * 144 + (16 * s + 8 * hh) * 2);
                const h8 k1 = *(const h8*)(Kc + (32 + q) * 144 + (16 * s + 8 * hh) * 2);
                S0 = __builtin_amdgcn_mfma_f32_32x32x16_f16(k0, qf[s], S0, 0, 0, 0);
                S1 = __builtin_amdgcn_mfma_f32_32x32x16_f16(k1, qf[s], S1, 0, 0, 0);
            }
            asm volatile("s_nop 15\n\ts_nop 15" : "+v"(S0), "+v"(S1));
            float mx = S0[0];
#pragma unroll
            for (int i = 1; i < 16; ++i) mx = fmaxf(mx, S0[i]);
#pragma unroll
            for (int i = 0; i < 16; ++i) mx = fmaxf(mx, S1[i]);
            if (kt == 0 || __any(mx > 6.f)) {
                mx = fmaxf(mx, __shfl_xor(mx, 32));
                const float dlt = (kt == 0) ? mx : fmaxf(mx, 0.f);
                const float alpha = (kt == 0) ? 0.f : __builtin_amdgcn_exp2f(-dlt);
                l_part *= alpha;
#pragma unroll
                for (int t = 0; t < 4; ++t)
#pragma unroll
                    for (int i = 0; i < 16; ++i) O[t][i] *= alpha;
#pragma unroll
                for (int i = 0; i < 16; ++i) { S0[i] -= dlt; S1[i] -= dlt; NEGM[i] -= dlt; }
            }
            float ps = 0.f;
#pragma unroll
            for (int i = 0; i < 16; ++i) { S0[i] = __builtin_amdgcn_exp2f(S0[i]); S1[i] = __builtin_amdgcn_exp2f(S1[i]); ps += S0[i] + S1[i]; }
            l_part += ps;
#pragma unroll
            for (int kb = 0; kb < 2; ++kb)
#pragma unroll
                for (int s2 = 0; s2 < 2; ++s2) {
                    h8 pf;
#pragma unroll
                    for (int j = 0; j < 8; ++j) pf[j] = (half_t)(kb ? S1[8 * s2 + j] : S0[8 * s2 + j]);
                    const unsigned char* vb = Vc + (kb * 32 + 16 * s2 + 4 * hh + qq) * 288 + 8 * (4 * blk + pp);
#pragma unroll
                    for (int t = 0; t < 4; ++t) {
                        const s4v lo = __builtin_amdgcn_ds_read_tr16_b64_v4i16((LAS s4v*)(vb + t * 64));
                        const s4v hi = __builtin_amdgcn_ds_read_tr16_b64_v4i16((LAS s4v*)(vb + 8 * 288 + t * 64));
                        const h4 lo4 = __builtin_bit_cast(h4, lo), hi4 = __builtin_bit_cast(h4, hi);
                        const h8 vf = __builtin_shufflevector(lo4, hi4, 0, 1, 2, 3, 4, 5, 6, 7);
                        O[t] = __builtin_amdgcn_mfma_f32_32x32x16_f16(vf, pf, O[t], 0, 0, 0);
                    }
                }
        }
        __syncthreads();
        const float lsum = l_part + __shfl_xor(l_part, 32);
        inv = 1.f / lsum;
        if (mp == 0) {
#pragma unroll
            for (int t = 0; t < 4; ++t)
#pragma unroll
                for (int i = 0; i < 8; ++i) { h2 v; v[0] = (half_t)(O[t][2 * i] * inv); v[1] = (half_t)(O[t][2 * i + 1] * inv); o0p[t * 8 + i] = v; }
        }
    }
    float ssq = 0.f;
    const float li = lam * inv;
#pragma unroll
    for (int t = 0; t < 4; ++t)
#pragma unroll
        for (int i = 0; i < 16; ++i) { const float of = (float)o0p[t * 8 + (i >> 1)][i & 1] - li * O[t][i]; O[t][i] = of; ssq += of * of; }
    ssq += __shfl_xor(ssq, 32);
    const float rs = rsqrtf(ssq * (1.f / 128.f) + 1e-6f) * (1.f - lam_init);
    const float* ng = p.in[I_DANG] + l * 128;
#pragma unroll
    for (int t = 0; t < 4; ++t)
#pragma unroll
        for (int g4 = 0; g4 < 4; ++g4) {
            const int dv0 = t * 32 + 8 * g4 + 4 * hh;
            const f32x4 gg = *(const f32x4*)(ng + dv0);
            h4 o;
#pragma unroll
            for (int j = 0; j < 4; ++j) o[j] = (half_t)(O[t][4 * g4 + j] * rs * gg[j]);
            *(h4*)(qrow + dv0) = o;
        }
}
DI void phase_attn(const Params& p, int l, unsigned char* smem) {
    const float* LAM = (const float*)(p.ws + OFF_LAM);
    const float lam = LAM[l], lam_init = LAM[4 + l];
    if (gridDim.x == 256) {
        const int c = (int)blockIdx.x, x = c & 7, slot = c >> 3;
#pragma unroll 1
        for (int r = 0; r < 2; ++r) { const int bh = x + 8 * (2 * r + (slot >> 4)); attn_item(p, l, bh * 16 + (slot & 15), smem, lam, lam_init); }
        if (slot < 4 && l + 1 < DEPTH) attn_item(p, l, 512 + x + 8 * slot, smem, lam, lam_init);
    } else {
        for (int item = blockIdx.x; item < 544; item += gridDim.x) attn_item(p, l, item, smem, lam, lam_init);
    }
}

DI void phase_post(const Params& p, int l) {
    const int tid_ = ltid(), wid = tid_ >> 6, lane = tid_ & 63, c4 = lane * 4;
    half_t* U = (half_t*)(p.ws + OFF_U);
    const half_t* RW = (const half_t*)(p.ws + OFF_BC);
    const float* CB = (const float*)(p.ws + OFF_CB);
    float hgn[4], lnw[4], lnb[4];
#pragma unroll
    for (int i = 0; i < 4; ++i) { hgn[i] = p.in[I_HGNG][l * 64 + ((c4 + i) & 63)]; lnw[i] = p.in[I_LNW][l * 256 + c4 + i]; lnb[i] = p.in[I_LNB][l * 256 + c4 + i]; }
    for (int m = blockIdx.x * 8 + wid; m < MROWS; m += gridDim.x * 8) {
        half_t* ur = U + (size_t)m * UST;
        { const h4 of = *(const h4*)(ur + U_OF + c4), ob = *(const h4*)(ur + U_OF + 256 + c4), sg = *(const h4*)(ur + U_HGG + c4);
          float o[4], ss = 0.f;
#pragma unroll
          for (int i = 0; i < 4; ++i) { o[i] = (float)of[i] + (float)ob[i]; ss += o[i] * o[i]; }
          ss = row16_sum(ss);
          const float rstd = rsqrtf(ss * (1.f / 64.f) + 1e-6f);
          h4 r;
#pragma unroll
          for (int i = 0; i < 4; ++i) r[i] = (half_t)(o[i] * rstd * hgn[i] * (float)sg[i]);
          *(h4*)(ur + U_MIX + c4) = r; }
        { const h4 yf = *(const h4*)(ur + U_YF + c4), yb = *(const h4*)(ur + U_YF + 256 + c4);
          const half_t* rp = RW + (size_t)m * RWC;
          const h4 vv = *(const h4*)(rp + R_V + c4), gt = *(const h4*)(rp + R_GATE + c4);
          const float bon = CB[(size_t)m * 4 + (lane >> 4)];
          float y[4], s1 = 0.f;
#pragma unroll
          for (int i = 0; i < 4; ++i) { y[i] = (float)yf[i] + (float)yb[i]; s1 += y[i]; }
          s1 = row16_sum(s1);
          const float mean = s1 * (1.f / 64.f);
          float s2 = 0.f;
#pragma unroll
          for (int i = 0; i < 4; ++i) { y[i] -= mean; s2 += y[i] * y[i]; }
          s2 = row16_sum(s2);
          const float rstd = rsqrtf(s2 * (1.f / 64.f) + 64e-5f);
          h4 r;
#pragma unroll
          for (int i = 0; i < 4; ++i) r[i] = (half_t)((y[i] * rstd * lnw[i] + lnb[i] + bon * (float)vv[i]) * (float)gt[i]);
          *(h4*)(ur + U_MIXRW + c4) = r; }
    }
}

DI void phase_final(const Params& p) {
    const int tid_ = ltid(), wid = tid_ >> 6, lane = tid_ & 63;
    const float* gn = p.in[I_FNG];
    for (int m0 = (blockIdx.x * 8 + wid) * 2; m0 < NB * TLAT; m0 += gridDim.x * 16) {
        f32x4 v[2][4]; float ss[2];
#pragma unroll
        for (int r = 0; r < 2; ++r)
#pragma unroll
            for (int i = 0; i < 4; ++i) v[r][i] = *(const f32x4*)(p.out + (size_t)(m0 + r) * DM + i * 256 + lane * 4);
#pragma unroll
        for (int r = 0; r < 2; ++r) {
            float a = 0.f;
#pragma unroll
            for (int i = 0; i < 4; ++i) a += v[r][i][0] * v[r][i][0] + v[r][i][1] * v[r][i][1] + v[r][i][2] * v[r][i][2] + v[r][i][3] * v[r][i][3];
            ss[r] = wave_sum(a);
        }
#pragma unroll
        for (int r = 0; r < 2; ++r) {
            const float rstd = rsqrtf(ss[r] * (1.f / DM) + 1e-6f);
#pragma unroll
            for (int i = 0; i < 4; ++i) { const int c = i * 256 + lane * 4; const f32x4 g = *(const f32x4*)(gn + c); *(f32x4*)(p.out + (size_t)(m0 + r) * DM + c) = v[r][i] * rstd * g; }
        }
    }
}

#define XB_TMO      128
#define XB_XCNT(j)  (256  + 64 * (j))
#define XB_XSUB(j)  (1280 + 64 * (j))
#define XB_XGEN(j)  (2304 + 64 * (j))
#define XB_TOP      3328
#define XB_TOPGEN   3392
#define XCD_BAR_WORDS 3456
#define XB_SPIN_CAP (1u << 22)

__device__ __forceinline__ unsigned xb_ld(unsigned* p)              { return __hip_atomic_load(p, __ATOMIC_RELAXED, __HIP_MEMORY_SCOPE_AGENT); }
__device__ __forceinline__ unsigned xb_add(unsigned* p, unsigned v) { return __hip_atomic_fetch_add(p, v, __ATOMIC_RELAXED, __HIP_MEMORY_SCOPE_AGENT); }
__device__ __forceinline__ unsigned xb_xcc_id() { return (unsigned)__builtin_amdgcn_s_getreg((3 << 11) | 20) & 0xFu; }
#define XB_SPIN(cond, bar) do { unsigned _sp = 0; while (cond) { __builtin_amdgcn_s_sleep(1); \
    if ((++_sp & 255u) == 0u) { if (xb_ld(&(bar)[XB_TMO])) break; if (_sp > XB_SPIN_CAP) { atomicAdd(&(bar)[XB_TMO], 1u); break; } } } } while (0)

struct XcdBarrier {
    unsigned* bar; unsigned x;
    volatile LAS unsigned* st;
};

__device__ __forceinline__ XcdBarrier xcd_barrier_post(unsigned* bar, volatile LAS unsigned* st) {
    XcdBarrier b; b.bar = bar; b.x = xb_xcc_id(); b.st = st;
    if (threadIdx.x == 0) (void)xb_add(&bar[XB_XCNT(b.x)], 1u);
    return b;
}
__device__ __forceinline__ void xcd_barrier_complete(unsigned* bar, unsigned x, unsigned& nloc, unsigned& nx) {
    const unsigned G = gridDim.x * gridDim.y * gridDim.z;
    unsigned sum, cnt, mine, sp = 0u;
    for (;;) {
        sum = 0u; cnt = 0u; mine = 0u;
#pragma unroll
        for (unsigned j = 0; j < 16; ++j) { const unsigned c = xb_ld(&bar[XB_XCNT(j)]); sum += c; cnt += (c > 0u) ? 1u : 0u; mine = (j == x) ? c : mine; }
        if (sum == G) break;
        __builtin_amdgcn_s_sleep(1);
        if ((++sp & 255u) == 0u) { if (xb_ld(&bar[XB_TMO])) break; if (sp > XB_SPIN_CAP) { atomicAdd(&bar[XB_TMO], 1u); break; } }
    }
    nloc = mine > 0u ? mine : 1u; nx = cnt > 0u ? cnt : 1u;
}

__device__ __forceinline__ void xcd_barrier(const XcdBarrier& b) {
    asm volatile("s_waitcnt vmcnt(0)" ::: "memory");
    __syncthreads();
    if (threadIdx.x == 0) {
        unsigned* bar = b.bar;
        __builtin_amdgcn_s_waitcnt(0);
        unsigned nloc = b.st[0], nx = b.st[1];
        if (nloc == 0u) { xcd_barrier_complete(bar, b.x, nloc, nx); b.st[0] = nloc; b.st[1] = nx; }
        const unsigned old = xb_add(&bar[XB_XSUB(b.x)], 1u);
        const unsigned gen = old / nloc;
        if (old + 1u == (gen + 1u) * nloc) {
            __builtin_amdgcn_fence(__ATOMIC_RELEASE, "agent");
            asm volatile("s_waitcnt vmcnt(0)" ::: "memory");
            const unsigned og = xb_add(&bar[XB_TOP], 1u);
            const unsigned tg = og / nx;
            if (og + 1u == (tg + 1u) * nx) xb_add(&bar[XB_TOPGEN], 1u);
            else XB_SPIN(xb_ld(&bar[XB_TOPGEN]) == tg, bar);
            __builtin_amdgcn_fence(__ATOMIC_ACQUIRE, "agent");
            xb_add(&bar[XB_XGEN(b.x)], 1u);
            asm volatile("s_waitcnt vmcnt(0)" ::: "memory");
        } else {
            XB_SPIN(xb_ld(&bar[XB_XGEN(b.x)]) == gen, bar);
            __builtin_amdgcn_fence(__ATOMIC_ACQUIRE, "agent");
            asm volatile("s_waitcnt vmcnt(0)" ::: "memory");
        }
    }
    __syncthreads();
}


__global__ void __launch_bounds__(512, 2) fwd_megakernel(Params p) {
    extern __shared__ __attribute__((aligned(16))) unsigned char smem[];
    cg::grid_group grid = cg::this_grid();
    pg8::StaticOrder S;
    __shared__ uint4 xb_words;
    unsigned* bar = (unsigned*)(p.ws + OFF_BAR);
    if (threadIdx.x == 0) xb_words = make_uint4(0u, 0u, 0u, 0u);
    if (blockIdx.x == 0) for (int i = threadIdx.x; i < XCD_BAR_WORDS; i += 512) bar[i] = 0u;
    phase_prologue(p, smem);
    __syncthreads();
    phase_convert(p, 0, smem);
    grid.sync();
    const XcdBarrier xb = xcd_barrier_post(bar, (volatile LAS unsigned*)&xb_words);
#pragma unroll 1
    for (int l_ = 0; l_ < DEPTH; ++l_) {
        int l = l_; asm volatile("" : "+s"(l));
        const float* MODl = (const float*)(p.ws + OFF_MOD) + (size_t)l * 9 * 6144;
        float* XC = (float*)(p.ws + OFF_XC);
        if (l > 0) phase_convert(p, l, smem);
        phase_norm(p, l, 0);
        xcd_barrier(xb);
        { pg8::Gemm g{(const half_t*)(p.ws + OFF_BC), (const half_t*)(p.ws + OFF_WIN), MROWS, UST, DM, DM, 0};
          S.init(g.M, g.N, (int)gridDim.x, (int)blockIdx.x);
          EpiIn E{(half_t*)(p.ws + OFF_U), (const float*)(p.ws + OFF_LB) + l * 512, (const float*)(p.ws + OFF_ROPE)};
          pg8::gemm_phase(( LAS unsigned char*)smem, g, S, E); }
        xcd_barrier(xb);
        phase_rwprep(p, l, smem);
        xcd_barrier(xb);
        phase_scan(p, l, smem);
        phase_attn(p, l, smem);
        xcd_barrier(xb);
        phase_post(p, l);
        xcd_barrier(xb);
        { pg8::Gemm g{(const half_t*)(p.ws + OFF_U) + U_MIX, (const half_t*)(p.ws + OFF_WOUT), MROWS, DM, DM, UST, 0};
          S.init(g.M, g.N, (int)gridDim.x, (int)blockIdx.x, l == DEPTH - 1);
          EpiRes E{l == 0 ? p.in[I_X] : (const float*)p.out, l == 0 ? p.in[I_CTX] : (const float*)XC, p.out, XC, MODl + 2048};
          pg8::gemm_phase((LAS unsigned char*)smem, g, S, E); }
        xcd_barrier(xb);
        phase_norm(p, l, 1);
        xcd_barrier(xb);
        { pg8::Gemm g{(const half_t*)(p.ws + OFF_BC), (const half_t*)(p.ws + OFF_WGU), MROWS, 2 * DFF, DM, DM, 0};
          S.init(g.M, g.N, (int)gridDim.x, (int)blockIdx.x, l == DEPTH - 1);
          EpiGU E{(half_t*)(p.ws + OFF_U)};
          pg8::gemm_phase((LAS unsigned char*)smem, g, S, E); }
        xcd_barrier(xb);
        { pg8::Gemm g{(const half_t*)(p.ws + OFF_U), (const half_t*)(p.ws + OFF_WDN), MROWS, DM, DFF, UST, 0};
          S.init(g.M, g.N, (int)gridDim.x, (int)blockIdx.x, (gridDim.x == 256 || l == DEPTH - 1) ? 1 : 0);
          EpiRes E{(const float*)p.out, (const float*)XC, p.out, XC, MODl + 5120};
          pg8::gemm_phase((LAS unsigned char*)smem, g, S, E);
          if (l + 1 < DEPTH && gridDim.x == 256) {
              const int item = (int)blockIdx.x, un = item >> 3, sl = item & 7;
              const int k0 = sl < 6 ? sl * 384 : 2304 + (sl - 6) * 256, kl = sl < 6 ? 384 : 256;
              pg8::Gemm gs{(const half_t*)(p.ws + OFF_U) + k0, (const half_t*)(p.ws + OFF_WDN) + k0, MROWS, DM, kl, UST, DFF};
              pg8::OneUnit S1{{(un >> 2) * 17, un & 3}};
              EpiPart EP{(float*)(p.ws + OFF_PART + (size_t)sl * SZ_PART1)};
              __syncthreads();
              pg8::gemm_phase((LAS unsigned char*)smem, gs, S1, EP);
          } }
        xcd_barrier(xb);
    }
    phase_final(p);
}

extern "C" void kernel_launch(void* const* d_in, const int* in_sizes, int n_in, void* d_out, int out_size, void* d_ws, size_t ws_size, hipStream_t stream) {
    static int grid_blocks = 0;
    if (grid_blocks == 0) {
        if (n_in != 33 || ws_size < WS_END) { fprintf(stderr, "kernel_launch: expected 33 inputs and >= %zu bytes of workspace; got %d inputs, %zu bytes\n", (size_t)WS_END, n_in, ws_size); grid_blocks = -1; return; }
        int dev = 0, cus = 0, per_cu = 0;
        hipGetDevice(&dev);
        hipDeviceGetAttribute(&cus, hipDeviceAttributeMultiprocessorCount, dev);
        if (hipFuncSetAttribute((const void*)fwd_megakernel, hipFuncAttributeMaxDynamicSharedMemorySize, LDS_BYTES) != hipSuccess) { fprintf(stderr, "kernel_launch: hipFuncSetAttribute failed\n"); grid_blocks = -1; return; }
        if (hipOccupancyMaxActiveBlocksPerMultiprocessor(&per_cu, (const void*)fwd_megakernel, 512, LDS_BYTES) != hipSuccess || per_cu < 1) { fprintf(stderr, "kernel_launch: occupancy query gave %d\n", per_cu); per_cu = 1; }
        (void)hipGetLastError();
        grid_blocks = cus * 1;
        if (grid_blocks > 256) grid_blocks = 256;
    }
    if (grid_blocks < 0) return;
    Params p{};
    for (int i = 0; i < 33; ++i) p.in[i] = (const float*)d_in[i];
    p.out = (float*)d_out; p.ws = (unsigned char*)d_ws;
    void* args[] = {&p};
    hipError_t e = hipLaunchCooperativeKernel((void*)fwd_megakernel, dim3(grid_blocks), dim3(512), args, LDS_BYTES, stream);
    if (e != hipSuccess) fprintf(stderr, "cooperative launch failed: %s (grid %d)\n", hipGetErrorString(e), grid_blocks);
}
```

```cpp
#include <hip/hip_runtime.h>
#include <hip/hip_cooperative_groups.h>
#include <cstdio>
namespace cg = cooperative_groups;

#define DI __device__ __forceinline__
#define LAS __attribute__((address_space(3)))
typedef _Float16 half_t;
typedef _Float16 h8 __attribute__((ext_vector_type(8)));
typedef _Float16 h4 __attribute__((ext_vector_type(4)));
typedef _Float16 h2 __attribute__((ext_vector_type(2)));
typedef float f32x4 __attribute__((ext_vector_type(4)));
typedef float f32x16 __attribute__((ext_vector_type(16)));
typedef short s4v __attribute__((__vector_size__(8)));

constexpr int DM = 1024, NB = 8, TLAT = 4096, LCTX = 256, NTOK = 4352, MROWS = NB * NTOK, DEPTH = 4;
constexpr int INC = 3776, UST = 3840, DFF = 2816, RWC = 3072;
constexpr int U_HGQ = 0, U_HGI = 256, U_HGKF = 512, U_HGG = 1024, U_DAQ = 1280, U_DAK = 1792, U_DAV = 2304, U_RW = 2816;
constexpr int U_YF = 2816, U_OF = 3328, U_MIX = 1024, U_MIXRW = 1792;
constexpr int R_V = 2560, R_GATE = 2816;
constexpr size_t OFF_U = 0, SZ_U = (size_t)MROWS * UST * 2;
constexpr size_t OFF_BC = OFF_U + SZ_U, SZ_BC = (size_t)MROWS * RWC * 2;
constexpr size_t OFF_WIN = OFF_BC + SZ_BC, SZ_WIN = (size_t)UST * DM * 2;
constexpr size_t OFF_WOUT = OFF_WIN + SZ_WIN, SZ_WOUT = (size_t)DM * DM * 2;
constexpr size_t OFF_WGU = OFF_WOUT + SZ_WOUT, SZ_WGU = (size_t)2 * DFF * DM * 2;
constexpr size_t OFF_WDN = OFF_WGU + SZ_WGU, SZ_WDN = (size_t)DM * DFF * 2;
constexpr size_t OFF_XC = OFF_WDN + SZ_WDN, SZ_XC = (size_t)NB * LCTX * DM * 4;
constexpr size_t OFF_MOD = OFF_XC + SZ_XC, SZ_MOD = (size_t)DEPTH * 9 * 6 * DM * 4;
constexpr size_t OFF_LB = OFF_MOD + SZ_MOD, SZ_LB = (size_t)DEPTH * 2 * 256 * 4;
constexpr size_t OFF_LAM = OFF_LB + SZ_LB, SZ_LAM = 256;
constexpr size_t OFF_ROPE = OFF_LAM + SZ_LAM, SZ_ROPE = 64 * 16 * 8;
constexpr size_t OFF_CB = OFF_ROPE + SZ_ROPE, SZ_CB = (size_t)MROWS * 4 * 4;
constexpr size_t OFF_BAR = OFF_CB + SZ_CB, SZ_BAR = 3456 * 4;
constexpr size_t OFF_PCB = OFF_BAR + SZ_BAR, SZ_PCB = (size_t)(MROWS / 16) * 512 * 2;
constexpr size_t WS_END = OFF_PCB + SZ_PCB;
constexpr size_t OFF_PART = OFF_BC + ((size_t)MROWS * DM * 2 + 4096), SZ_PART1 = (size_t)NB * LCTX * DM * 4;
constexpr int LDS_BYTES = 131072;
constexpr float QSCALE = 0.125f * 1.4426950408889634f;

struct Params { const float* in[33]; float* out; unsigned char* ws; };
enum { I_X = 0, I_C, I_CTX, I_CCTX, I_ADAW, I_ADAB, I_N1G, I_N2G, I_WIN, I_WOUT, I_HGLB, I_HGNG, I_LQ1, I_LK1, I_LQ2, I_LK2, I_DANG, I_MUP, I_MUN,
       I_W0, I_W2, I_A0, I_A2, I_G2, I_KK, I_KA, I_RK, I_LNW, I_LNB, I_FG, I_FU, I_FD, I_FNG };

DI int ltid() { int t = threadIdx.x; asm volatile("" : "+v"(t)); return t; }
DI float wave_sum(float v) {
#pragma unroll
    for (int o = 32; o; o >>= 1) v += __shfl_xor(v, o);
    return v;
}
DI float dpp_add(float v, const int ctrl_unused) { return v; }
#define DPP_ADD(v, ctrl) ((v) + __int_as_float(__builtin_amdgcn_mov_dpp(__float_as_int(v), (ctrl), 0xf, 0xf, true)))
DI float row16_sum(float v) {
    v = DPP_ADD(v, 0xB1);
    v = DPP_ADD(v, 0x4E);
    v = DPP_ADD(v, 0x124);
    v = DPP_ADD(v, 0x128);
    return v;
}
DI float sigmoidf_(float x) { return __builtin_amdgcn_rcpf(1.f + __expf(-x)); }

DI const float* xsrc_row(const Params& p, int l, int m) {
    const int b = m / NTOK, n = m - b * NTOK;
    if (n < LCTX) return (l == 0 ? p.in[I_CTX] : (const float*)(p.ws + OFF_XC)) + ((size_t)b * LCTX + n) * DM;
    return (l == 0 ? p.in[I_X] : (const float*)p.out) + ((size_t)b * TLAT + (n - LCTX)) * DM;
}

namespace pg8 {
constexpr int BM = 256, BK = 64, HALF = 128, HTB = HALF * BK * 2, STAGE_BYTES = 8 * HTB, NXCD = 8, WGM = 8;
DI int lds_byte(int r, int c) { const int st = (r >> 4) * 2 + (c >> 5), rr = r & 15, cc = c & 31, ob = rr * 64 + cc * 2; return st * 1024 + (ob ^ (((ob >> 9) & 1) << 5)); }
DI void stage_rc(int b, int& R, int& C) { const int st = b / 1024, sb = b % 1024, swz = sb ^ (((sb >> 9) & 1) << 5); R = (st >> 1) * 16 + swz / 64; C = (st & 1) * 32 + (swz % 64) / 2; }
DI int perm32(int rho) { const int n = rho >> 4, i = rho & 15; return 8 * (i >> 2) + 4 * n + (i & 3); }
struct Unit { int pm, pn; };
struct Gemm { const half_t* A; const half_t* Bt; int M, N, K, lda, ldb; };
struct StaticOrder {
    int nM, nN, nwg, G, c, skipctx;
    DI void init(int M, int N, int G_, int c_, int skipctx_ = 0) { nM = M / BM; if (skipctx_) nM -= nM / 17; nN = N / BM; nwg = nM * nN; G = G_; c = c_; skipctx = skipctx_; }
    DI bool next(int i, Unit& u) const {
        const long L = (long)i * G + c; if (L >= nwg) return false;
        int wgid = (int)L; { const int q = nwg / NXCD, r = nwg % NXCD, xcd = wgid % NXCD, off = wgid / NXCD; wgid = (xcd < r ? xcd * (q + 1) : r * (q + 1) + (xcd - r) * q) + off; }
        const int nig = WGM * nN, gid = wgid / nig, fm = gid * WGM, gsz = (nM - fm) < WGM ? (nM - fm) : WGM;
        u.pm = fm + ((wgid % nig) % gsz); u.pn = (wgid % nig) / gsz; if (skipctx) u.pm += u.pm / 16 + 1; return true;
    }
};

struct OneUnit { Unit u; DI bool next(int i, Unit& o) const { o = u; return i == 0; } };
template <class Epi, class Sched>
DI void gemm_phase(LAS unsigned char* lds, const Gemm g, const Sched& S, const Epi& E) {
    const int tid = ltid(), wid = __builtin_amdgcn_readfirstlane(tid >> 6), lane = tid & 63, wr = wid >> 2, wc = wid & 3, fr = lane & 15, fq = lane >> 4;
    const int K = g.K, nt = K / BK, lda = g.lda, ldb = g.ldb ? g.ldb : g.K;
    unsigned voffA[2], voffB[2];
#pragma unroll
    for (int i = 0; i < 2; ++i) { int R, C; stage_rc(tid * 16 + i * 8192, R, C); const int Rb = Epi::PERM ? ((R & ~31) + perm32(R & 31)) : R;
        voffA[i] = (unsigned)(R * lda + C) * 2u; voffB[i] = (unsigned)(Rb * ldb + C) * 2u; }
    const size_t kstep = (size_t)(BK * 2);
    const size_t hstepA = (size_t)HALF * lda * 2, hstepB = (size_t)HALF * ldb * 2;
    const size_t tstepA = 2 * hstepA, tstepB = 2 * hstepB;
    const unsigned ldsw = (unsigned)wid * 1024u;
    const int aoff = lds_byte(wr * 64 + fr, fq * 8), boff = lds_byte(wc * 32 + fr, fq * 8);
#define PG8_SA(b, h) (((b) * 2 + (h)) * HTB)
#define PG8_SB(b, h) ((4 + (b) * 2 + (h)) * HTB)
#define PG8_STAGE(bufoff, gbase, voff) do { _Pragma("unroll") for (int _i = 0; _i < 2; ++_i) \
        __builtin_amdgcn_global_load_lds((const unsigned*)((const char*)(gbase) + (voff)[_i]), (LAS unsigned*)(lds + (bufoff) + ldsw + _i * 8192), 16, 0, 0); } while (0)
#define PG8_LDA(dst, b, h) do { _Pragma("unroll") for (int m = 0; m < 4; ++m) _Pragma("unroll") for (int k = 0; k < 2; ++k) dst[m][k] = *(const LAS h8*)(lds + PG8_SA(b, h) + aoff + m * 2048 + k * 1024); } while (0)
#define PG8_LDB(dst, b, h) do { _Pragma("unroll") for (int n = 0; n < 2; ++n) _Pragma("unroll") for (int k = 0; k < 2; ++k) dst[n][k] = *(const LAS h8*)(lds + PG8_SB(b, h) + boff + n * 2048 + k * 1024); } while (0)
#define PG8_MMA(ai, bj, At, Bt) do { __builtin_amdgcn_s_setprio(1); _Pragma("unroll") for (int m = 0; m < 4; ++m) _Pragma("unroll") for (int n = 0; n < 2; ++n) _Pragma("unroll") for (int k = 0; k < 2; ++k) \
        acc[ai][bj][m][n] = __builtin_amdgcn_mfma_f32_16x16x32_f16(Bt[n][k], At[m][k], acc[ai][bj][m][n], 0, 0, 0); __builtin_amdgcn_s_setprio(0); } while (0)
#define PG8_WAIT_V(n) asm volatile("s_waitcnt vmcnt(" #n ")" ::: "memory")
#define PG8_WAIT_L(n) asm volatile("s_waitcnt lgkmcnt(" #n ")" ::: "memory")
#define PG8_BAR __builtin_amdgcn_s_barrier()
#define PG8_SCHED __builtin_amdgcn_sched_barrier(0)
    Unit cur, nxt; int ui = 0;
    if (!S.next(0, cur)) return;
    f32x4 acc[2][2][4][2];
#pragma unroll
    for (int a = 0; a < 2; ++a)
#pragma unroll
        for (int b = 0; b < 2; ++b)
#pragma unroll
            for (int m = 0; m < 4; ++m)
#pragma unroll
                for (int n = 0; n < 2; ++n) acc[a][b][m][n] = (f32x4){0.f, 0.f, 0.f, 0.f};
    h8 At[4][2], B0[2][2], B1[2][2];
    const char* cA = (const char*)g.A + (size_t)cur.pm * tstepA; const char* cB = (const char*)g.Bt + (size_t)cur.pn * tstepB;
    PG8_STAGE(PG8_SB(0, 0), cB, voffB); PG8_STAGE(PG8_SA(0, 0), cA, voffA); PG8_STAGE(PG8_SB(0, 1), cB + hstepB, voffB); PG8_STAGE(PG8_SA(0, 1), cA + hstepA, voffA);
    if (wr == 1) PG8_BAR;
    PG8_WAIT_V(4); PG8_BAR;
    PG8_STAGE(PG8_SB(1, 0), cB + kstep, voffB); PG8_STAGE(PG8_SA(1, 0), cA + kstep, voffA); PG8_STAGE(PG8_SB(1, 1), cB + hstepB + kstep, voffB);
    PG8_WAIT_V(6); PG8_BAR;
    for (;;) {
        const bool has_next = S.next(ui + 1, nxt);
        const char* nA = has_next ? (const char*)g.A + (size_t)nxt.pm * tstepA : cA; const char* nB = has_next ? (const char*)g.Bt + (size_t)nxt.pn * tstepB : cB;
        for (int t = 0; t < nt; t += 2) {
            const bool last = (t == nt - 2);
            const char* a1 = cA + (size_t)(t + 1) * kstep;
            const char* a2 = last ? nA : cA + (size_t)(t + 2) * kstep; const char* b2 = last ? nB : cB + (size_t)(t + 2) * kstep;
            const char* a3 = a2 + kstep; const char* b3 = b2 + kstep;
            PG8_LDB(B0, 0, 0); PG8_SCHED; PG8_LDA(At, 0, 0); PG8_STAGE(PG8_SA(1, 1), a1 + hstepA, voffA);
            PG8_WAIT_L(8); PG8_BAR; PG8_WAIT_L(0); PG8_MMA(0, 0, At, B0); PG8_BAR; PG8_SCHED;
            PG8_LDB(B1, 0, 1); PG8_STAGE(PG8_SB(0, 0), b2, voffB);
            PG8_BAR; PG8_WAIT_L(0); PG8_MMA(0, 1, At, B1); PG8_BAR;
            PG8_LDA(At, 0, 1); PG8_STAGE(PG8_SA(0, 0), a2, voffA);
            PG8_BAR; PG8_WAIT_L(0); PG8_MMA(1, 0, At, B0); PG8_BAR; PG8_SCHED;
            PG8_STAGE(PG8_SB(0, 1), b2 + hstepB, voffB);
            PG8_WAIT_V(6); PG8_BAR; PG8_MMA(1, 1, At, B1); PG8_BAR;
            PG8_LDB(B0, 1, 0); PG8_SCHED; PG8_LDA(At, 1, 0); PG8_STAGE(PG8_SA(0, 1), a2 + hstepA, voffA);
            PG8_WAIT_L(8); PG8_BAR; PG8_WAIT_L(0); PG8_MMA(0, 0, At, B0); PG8_BAR; PG8_SCHED;
            PG8_LDB(B1, 1, 1); PG8_STAGE(PG8_SB(1, 0), b3, voffB);
            PG8_BAR; PG8_WAIT_L(0); PG8_MMA(0, 1, At, B1); PG8_BAR;
            PG8_LDA(At, 1, 1); PG8_STAGE(PG8_SA(1, 0), a3, voffA);
            PG8_BAR; PG8_WAIT_L(0); PG8_MMA(1, 0, At, B0); PG8_BAR; PG8_SCHED;
            PG8_STAGE(PG8_SB(1, 1), b3 + hstepB, voffB);
            PG8_WAIT_V(6); PG8_BAR; PG8_MMA(1, 1, At, B1); PG8_BAR;
        }
        E(acc, cur, wr, wc, fr, fq);
        if (!has_next) break;
#pragma unroll
        for (int a = 0; a < 2; ++a)
#pragma unroll
            for (int b = 0; b < 2; ++b)
#pragma unroll
                for (int m = 0; m < 4; ++m)
#pragma unroll
                    for (int n = 0; n < 2; ++n) acc[a][b][m][n] = (f32x4){0.f, 0.f, 0.f, 0.f};
        cur = nxt; cA = nA; cB = nB; ++ui;
    }
    PG8_WAIT_V(0);
    if (wr == 0) PG8_BAR;
    PG8_BAR;
#undef PG8_SA
#undef PG8_SB
#undef PG8_STAGE
#undef PG8_LDA
#undef PG8_LDB
#undef PG8_MMA
#undef PG8_WAIT_V
#undef PG8_WAIT_L
#undef PG8_BAR
#undef PG8_SCHED
}
}

struct EpiIn {
    static constexpr bool PERM = true;
    half_t* U; const float* lb; const float* rope;
    DI void operator()(const f32x4 (&acc)[2][2][4][2], const pg8::Unit& u, int wr, int wc, int fr, int fq) const {
        const int pn = u.pn, qq = u.pm % 17; const bool latent = qq != 0; const int t0 = (qq - 1) * 256;
#pragma unroll
        for (int ai = 0; ai < 2; ++ai)
#pragma unroll
            for (int m = 0; m < 4; ++m) {
                const int rl = ai * 128 + wr * 64 + m * 16 + fr;
                half_t* rowp = U + (size_t)(u.pm * 256 + rl) * UST + pn * 256 + wc * 32 + 8 * fq;
#pragma unroll
                for (int bj = 0; bj < 2; ++bj) {
                    f32x4 v0 = acc[ai][bj][m][0], v1 = acc[ai][bj][m][1];
                    const int cl = bj * 128 + wc * 32 + 8 * fq;
                    if (pn == 2 || pn == 3) {
                        const float* lp = lb + (pn - 2) * 256 + cl;
                        const f32x4 l0 = *(const f32x4*)lp, l1 = *(const f32x4*)(lp + 4);
#pragma unroll
                        for (int j = 0; j < 4; ++j) { v0[j] = (1.f - l0[j]) * __builtin_amdgcn_rcpf(1.f + __expf(v0[j])); v1[j] = (1.f - l1[j]) * __builtin_amdgcn_rcpf(1.f + __expf(v1[j])); }
                    } else if (pn == 4) {
#pragma unroll
                        for (int j = 0; j < 4; ++j) { v0[j] = v0[j] * __builtin_amdgcn_rcpf(1.f + __expf(-v0[j])); v1[j] = v1[j] * __builtin_amdgcn_rcpf(1.f + __expf(-v1[j])); }
                    } else if (pn >= 5 && pn <= 8) {
                        if (latent) {
                            const int t = t0 + rl; const int pos = (wc & 1) ? (t & 63) : (t >> 6);
                            const f32x4* tb = (const f32x4*)(rope + (size_t)(pos * 16 + fq * 4) * 2);
                            const f32x4 cs01 = tb[0], cs23 = tb[1];
                            const float cc[4] = {cs01[0], cs01[2], cs23[0], cs23[2]}, ss[4] = {cs01[1], cs01[3], cs23[1], cs23[3]};
#pragma unroll
                            for (int j = 0; j < 4; ++j) { const float t1 = v0[j], t2 = v1[j]; v0[j] = t1 * cc[j] - t2 * ss[j]; v1[j] = t1 * ss[j] + t2 * cc[j]; }
                        }
                        if (pn <= 6) { v0 *= QSCALE; v1 *= QSCALE; }
                    }
                    h8 o;
#pragma unroll
                    for (int j = 0; j < 4; ++j) { o[j] = (half_t)v0[j]; o[4 + j] = (half_t)v1[j]; }
                    *(h8*)(rowp + bj * 128) = o;
                }
            }
    }
};
struct EpiRes {
    static constexpr bool PERM = false;
    const float* src_lat; const float* src_ctx; float* dst_lat; float* dst_ctx; const float* gate;
    DI void operator()(const f32x4 (&acc)[2][2][4][2], const pg8::Unit& u, int wr, int wc, int fr, int fq) const {
        const int b = u.pm / 17, qq = u.pm % 17;
        const float* srcb; float* dstb; int jm;
        if (qq == 0) { const size_t off = (size_t)b * LCTX * DM; srcb = src_ctx + off; dstb = dst_ctx + off; jm = 8; }
        else { const size_t off = ((size_t)b * TLAT + (size_t)(qq - 1) * 256) * DM; srcb = src_lat + off; dstb = dst_lat + off; jm = b; }
        const float* g = gate + (size_t)jm * 6144;
        const int row0 = wr * 64 + fr, col0 = u.pn * 256 + wc * 32 + 4 * fq;
        f32x4 gv[2][2];
#pragma unroll
        for (int bj = 0; bj < 2; ++bj)
#pragma unroll
            for (int n = 0; n < 2; ++n) gv[bj][n] = *(const f32x4*)(g + col0 + bj * 128 + n * 16);
#pragma unroll
        for (int ai = 0; ai < 2; ++ai)
#pragma unroll
            for (int m = 0; m < 4; ++m) {
                const size_t ro = (size_t)(row0 + ai * 128 + m * 16) * DM + col0;
#pragma unroll
                for (int bj = 0; bj < 2; ++bj)
#pragma unroll
                    for (int n = 0; n < 2; ++n) {
                        const f32x4 old = *(const f32x4*)(srcb + ro + bj * 128 + n * 16);
                        *(f32x4*)(dstb + ro + bj * 128 + n * 16) = old + gv[bj][n] * acc[ai][bj][m][n];
                    }
            }
    }
};
struct EpiPart {
    static constexpr bool PERM = false;
    float* P;
    DI void operator()(const f32x4 (&acc)[2][2][4][2], const pg8::Unit& u, int wr, int wc, int fr, int fq) const {
        const int b = u.pm / 17, row0 = b * 256 + wr * 64 + fr, col0 = u.pn * 256 + wc * 32 + 4 * fq;
#pragma unroll
        for (int ai = 0; ai < 2; ++ai)
#pragma unroll
            for (int m = 0; m < 4; ++m)
#pragma unroll
                for (int bj = 0; bj < 2; ++bj)
#pragma unroll
                    for (int n = 0; n < 2; ++n) *(f32x4*)(P + (size_t)(row0 + ai * 128 + m * 16) * DM + col0 + bj * 128 + n * 16) = acc[ai][bj][m][n];
    }
};
struct EpiGU {
    static constexpr bool PERM = true;
    half_t* Hd;
    DI void operator()(const f32x4 (&acc)[2][2][4][2], const pg8::Unit& u, int wr, int wc, int fr, int fq) const {
#pragma unroll
        for (int ai = 0; ai < 2; ++ai)
#pragma unroll
            for (int m = 0; m < 4; ++m) {
                const int row = u.pm * 256 + ai * 128 + wr * 64 + m * 16 + fr;
                h8 o;
#pragma unroll
                for (int n = 0; n < 2; ++n)
#pragma unroll
                    for (int j = 0; j < 4; ++j) { const float gt = acc[ai][0][m][n][j], up = acc[ai][1][m][n][j]; o[4 * n + j] = (half_t)(gt * __builtin_amdgcn_rcpf(1.f + __expf(-gt)) * up); }
                *(h8*)(Hd + (size_t)row * UST + u.pn * 128 + wc * 32 + 8 * fq) = o;
            }
    }
};

DI void sincos_d(double a, float& c, float& s) {
    const double r = a - 6.283185307179586 * __builtin_rint(a * 0.15915494309189535);
    const double r2 = r * r;
    double sc = 1.0, ss = 1.0;
#pragma unroll
    for (int k = 13; k >= 1; --k) { sc = 1.0 - sc * r2 * (1.0 / (double)((2 * k - 1) * (2 * k))); ss = 1.0 - ss * r2 * (1.0 / (double)((2 * k) * (2 * k + 1))); }
    c = (float)sc; s = (float)(ss * r);
}
DI void phase_prologue(const Params& p, unsigned char* smem) {
    const int tid = ltid(), bid = blockIdx.x, nb = gridDim.x;
    float* sc = (float*)smem;
    float* red = sc + 9 * 1024;
    for (int i = tid; i < 9 * 1024; i += 512) { const int j = i >> 10, k = i & 1023; const float v = (j < 8) ? p.in[I_C][j * 1024 + k] : p.in[I_CCTX][k]; sc[i] = v / (1.f + __expf(-v)); }
    __syncthreads();
    float* MOD = (float*)(p.ws + OFF_MOD);
    for (int item = bid; item < 192; item += nb) {
        const int l = item / 48, cb = item % 48, cl = tid & 127, kq = tid >> 7, col = cb * 128 + cl;
        const float* W = p.in[I_ADAW] + (size_t)l * 1024 * 6144 + col;
        float a0 = 0, a1 = 0, a2 = 0, a3 = 0, a4 = 0, a5 = 0, a6 = 0, a7 = 0, a8 = 0;
#pragma unroll 16
        for (int k = kq * 256; k < kq * 256 + 256; ++k) {
            const float w = W[(size_t)k * 6144];
            a0 += sc[k] * w; a1 += sc[1024 + k] * w; a2 += sc[2048 + k] * w; a3 += sc[3072 + k] * w; a4 += sc[4096 + k] * w;
            a5 += sc[5120 + k] * w; a6 += sc[6144 + k] * w; a7 += sc[7168 + k] * w; a8 += sc[8192 + k] * w;
        }
        float* r = red + (kq * 128 + cl) * 9;
        r[0] = a0; r[1] = a1; r[2] = a2; r[3] = a3; r[4] = a4; r[5] = a5; r[6] = a6; r[7] = a7; r[8] = a8;
        __syncthreads();
        for (int i = tid; i < 128 * 9; i += 512) {
            const int c2 = i / 9, j = i % 9;
            const float s = red[(0 * 128 + c2) * 9 + j] + red[(1 * 128 + c2) * 9 + j] + red[(2 * 128 + c2) * 9 + j] + red[(3 * 128 + c2) * 9 + j];
            const int cc = cb * 128 + c2;
            MOD[((size_t)l * 9 + j) * 6144 + cc] = s + p.in[I_ADAB][l * 6144 + cc];
        }
        __syncthreads();
    }
    if (bid == nb - 1) {
        float* LB = (float*)(p.ws + OFF_LB);
        { const int d = tid >> 8, j = tid & 255;
          float x[4], mx = -1e30f;
#pragma unroll
          for (int i = 0; i < 4; ++i) { x[i] = p.in[I_HGLB][(d * 4 + i) * 256 + j]; mx = fmaxf(mx, x[i]); }
          float sum = 0;
#pragma unroll
          for (int i = 0; i < 4; ++i) { x[i] = expf(x[i] - mx); sum += x[i]; }
          float cum = 0;
#pragma unroll
          for (int i = 0; i < 4; ++i) { if (i > 0) cum += x[i] / sum; LB[(i * 2 + d) * 256 + j] = cum; } }
        if (tid < 4) {
            const int l = tid; float s1 = 0, s2 = 0;
            for (int i = 0; i < 64; ++i) { s1 += p.in[I_LQ1][l * 64 + i] * p.in[I_LK1][l * 64 + i]; s2 += p.in[I_LQ2][l * 64 + i] * p.in[I_LK2][l * 64 + i]; }
            const float li = 0.8f - 0.6f * expf(-0.3f * (float)l);
            float* LAM = (float*)(p.ws + OFF_LAM);
            LAM[l] = expf(s1) - expf(s2) + li; LAM[4 + l] = li;
        }
    }
    if (bid == nb - 2 || nb == 1) {
        float* RT = (float*)(p.ws + OFF_ROPE);
        for (int i = tid; i < 1024; i += 512) {
            const int pos = i >> 4, f = i & 15;
            const float invf = powf(10000.f, -(float)f / 16.f);
            const float ang = (float)pos * invf;
            float c, s; sincos_d((double)ang, c, s);
            RT[2 * i] = c; RT[2 * i + 1] = s;
        }
    }
}

DI void conv_tile(const float* src, int Nsrc, int scol0, bool rope_perm, bool zero, half_t* dst, int K, int drow0, int k0, float* tile) {
    const int tid = ltid();
#pragma unroll
    for (int i = 0; i < 8; ++i) {
        const int idx = tid + 512 * i, kk = idx >> 6, nn = idx & 63;
        int sc = nn;
        if (rope_perm) { const int grp = nn >> 3, w = nn & 7; sc = (w < 4) ? grp * 4 + w : 32 + grp * 4 + (w - 4); }
        tile[nn * 65 + kk] = zero ? 0.f : src[(size_t)(k0 + kk) * Nsrc + scol0 + sc];
    }
    __syncthreads();
    { const int nn = tid >> 3, k8 = (tid & 7) * 8; h8 o;
#pragma unroll
      for (int e = 0; e < 8; ++e) o[e] = (half_t)tile[nn * 65 + k8 + e];
      *(h8*)(dst + (size_t)(drow0 + nn) * K + k0 + k8) = o; }
    __syncthreads();
}
DI void phase_convert(const Params& p, int l, unsigned char* smem) {
    float* tile = (float*)smem;
    for (int t = blockIdx.x; t < 3328; t += gridDim.x) {
        if (t < 960) { const int nb64 = t >> 4, kb = t & 15, n0 = nb64 * 64;
            conv_tile(p.in[I_WIN] + (size_t)l * DM * INC, INC, n0, n0 >= U_DAQ && n0 < U_DAV, n0 >= INC, (half_t*)(p.ws + OFF_WIN), DM, n0, kb * 64, tile); }
        else if (t < 1216) { const int t2 = t - 960, nb64 = t2 >> 4, kb = t2 & 15;
            conv_tile(p.in[I_WOUT] + (size_t)l * DM * DM, DM, nb64 * 64, false, false, (half_t*)(p.ws + OFF_WOUT), DM, nb64 * 64, kb * 64, tile); }
        else if (t < 2624) { const int t2 = t - 1216, nb64 = t2 >> 4, kb = t2 & 15, n0 = nb64 * 64, pn = n0 >> 8, within = n0 & 255, bj = within >> 7, j0 = within & 127;
            conv_tile(p.in[bj ? I_FU : I_FG] + (size_t)l * DM * DFF, DFF, pn * 128 + j0, false, false, (half_t*)(p.ws + OFF_WGU), DM, n0, kb * 64, tile); }
        else { const int t2 = t - 2624, nb64 = t2 / 44, kb = t2 % 44;
            conv_tile(p.in[I_FD] + (size_t)l * DFF * DM, DM, nb64 * 64, false, false, (half_t*)(p.ws + OFF_WDN), DFF, nb64 * 64, kb * 64, tile); }
    }
}
DI void phase_norm(const Params& p, int l, int which) {
    const int tid_ = ltid(), wid = tid_ >> 6, lane = tid_ & 63;
    half_t* H = (half_t*)(p.ws + OFF_BC);
    const float* gn = p.in[which ? I_N2G : I_N1G] + l * DM;
    const float* MOD = (const float*)(p.ws + OFF_MOD) + (size_t)l * 9 * 6144 + which * 3072;
    for (int m0 = (blockIdx.x * 8 + wid) * 2; m0 < MROWS; m0 += gridDim.x * 16) {
        if (which == 1 && l == DEPTH - 1 && (m0 % NTOK) < LCTX) continue;
        f32x4 v[2][4]; float ss[2];
#pragma unroll
        for (int r = 0; r < 2; ++r) {
            const float* xr = xsrc_row(p, which ? 1 : l, m0 + r);
#pragma unroll
            for (int i = 0; i < 4; ++i) v[r][i] = *(const f32x4*)(xr + i * 256 + lane * 4);
            if (which == 0 && l > 0 && gridDim.x == 256) {
                const int m = m0 + r, b = m / NTOK, n = m - b * NTOK;
                if (n < LCTX) {
                    const float* g2c = (const float*)(p.ws + OFF_MOD) + ((size_t)(l - 1) * 9 + 8) * 6144 + 5120;
                    const size_t ro = ((size_t)b * LCTX + n) * DM;
#pragma unroll
                    for (int i = 0; i < 4; ++i) {
                        const int c = i * 256 + lane * 4;
                        f32x4 acc = *(const f32x4*)(p.ws + OFF_PART + (ro + c) * 4);
#pragma unroll
                        for (int sl = 1; sl < 8; ++sl) acc += *(const f32x4*)(p.ws + OFF_PART + (size_t)sl * SZ_PART1 + (ro + c) * 4);
                        v[r][i] += *(const f32x4*)(g2c + c) * acc;
                        *(f32x4*)((float*)(p.ws + OFF_XC) + ro + c) = v[r][i];
                    }
                }
            }
        }
#pragma unroll
        for (int r = 0; r < 2; ++r) {
            float a = 0.f;
#pragma unroll
            for (int i = 0; i < 4; ++i) a += v[r][i][0] * v[r][i][0] + v[r][i][1] * v[r][i][1] + v[r][i][2] * v[r][i][2] + v[r][i][3] * v[r][i][3];
            ss[r] = wave_sum(a);
        }
#pragma unroll
        for (int r = 0; r < 2; ++r) {
            const int m = m0 + r, b = m / NTOK, n = m - b * NTOK;
            const float rstd = rsqrtf(ss[r] * (1.f / DM) + 1e-6f);
            const float* md = MOD + (size_t)(n < LCTX ? 8 : b) * 6144;
#pragma unroll
            for (int i = 0; i < 4; ++i) {
                const int c = i * 256 + lane * 4;
                const f32x4 g = *(const f32x4*)(gn + c), sh = *(const f32x4*)(md + c), sc = *(const f32x4*)(md + 1024 + c);
                h4 o;
#pragma unroll
                for (int j = 0; j < 4; ++j) o[j] = (half_t)(v[r][i][j] * rstd * g[j] * (1.f + sc[j]) + sh[j]);
                *(h4*)(H + (size_t)m * DM + c) = o;
            }
        }
    }
}

#define DPP_MOV_F(v, ctrl) __int_as_float(__builtin_amdgcn_mov_dpp(__float_as_int(v), (ctrl), 0xf, 0xf, true))
#define DPP_SHR_ZERO(v, ctrl) __int_as_float(__builtin_amdgcn_update_dpp(0, __float_as_int(v), (ctrl), 0xf, 0xf, false))
#define DPP_SHR_ONE(v, ctrl) __int_as_float(__builtin_amdgcn_update_dpp(0x3f800000, __float_as_int(v), (ctrl), 0xf, 0xf, false))
DI void rw_chunkprep(half_t* RW, half_t* PCB, int g, int wid, int lane, half_t* scr  ) {
    const int d = wid >> 2, h = wid & 3, c = lane & 15, q = lane >> 4;
    const int ti = d ? 15 - c : c;
    half_t* blk0 = RW + (size_t)(g * 16) * RWC + (d * 4 + h) * 320;
    half_t* myb = blk0 + (size_t)ti * RWC;
    float nkk[16], w[16], bb[16], kd[16], r[16];
#pragma unroll
    for (int s = 0; s < 2; ++s) {
        const int kq0 = 8 * s + 2 * q;
        const h8 a0 = *(const h8*)(myb + kq0 * 8), a1 = *(const h8*)(myb + kq0 * 8 + 8);
        const h8 b0 = *(const h8*)(myb + 128 + kq0 * 8), b1 = *(const h8*)(myb + 128 + kq0 * 8 + 8);
        const h8 r8 = *(const h8*)(myb + 256 + kq0 * 4);
#pragma unroll
        for (int e = 0; e < 4; ++e) {
            nkk[8 * s + e] = (float)a0[e]; w[8 * s + e] = 1.f + (float)a0[4 + e]; nkk[8 * s + 4 + e] = (float)a1[e]; w[8 * s + 4 + e] = 1.f + (float)a1[4 + e];
            bb[8 * s + e] = (float)b0[e]; kd[8 * s + e] = (float)b0[4 + e]; bb[8 * s + 4 + e] = (float)b1[e]; kd[8 * s + 4 + e] = (float)b1[4 + e];
            r[8 * s + e] = (float)r8[e]; r[8 * s + 4 + e] = (float)r8[4 + e];
        }
    }
    asm volatile("s_waitcnt vmcnt(0)" ::: "memory");
    h8 Ah[2], Rh[2], bh[2], kh[2], At8[2], Rt8[2], PC8[2];
    half_t btv[16], ktv[16];
#pragma unroll
    for (int jj = 0; jj < 16; ++jj) {
        float P = w[jj];
        P *= DPP_SHR_ONE(P, 0x111); P *= DPP_SHR_ONE(P, 0x112); P *= DPP_SHR_ONE(P, 0x114); P *= DPP_SHR_ONE(P, 0x118);
        const float Pm1 = DPP_SHR_ONE(P, 0x111);
        const float PC = DPP_MOV_F(P, 0x15F), P7 = DPP_MOV_F(P, 0x157);
        const float rP = __builtin_amdgcn_rcpf(P), rP7 = __builtin_amdgcn_rcpf(P7);
        const float At = nkk[jj] * Pm1, Rt = r[jj] * P;
        At8[jj >> 3][jj & 7] = (half_t)At; Rt8[jj >> 3][jj & 7] = (half_t)Rt; PC8[jj >> 3][jj & 7] = (half_t)PC;
        btv[jj] = (half_t)(bb[jj] * PC * rP); ktv[jj] = (half_t)(kd[jj] * PC * rP);
        Ah[jj >> 3][jj & 7] = (half_t)(At * rP7); Rh[jj >> 3][jj & 7] = (half_t)(Rt * rP7);
        bh[jj >> 3][jj & 7] = (half_t)(bb[jj] * P7 * rP); kh[jj >> 3][jj & 7] = (half_t)(kd[jj] * P7 * rP);
    }
    f32x4 ab = {0.f, 0.f, 0.f, 0.f}, ak = ab, rb = ab, rk = ab;
#pragma unroll
    for (int s = 0; s < 2; ++s) {
        ab = __builtin_amdgcn_mfma_f32_16x16x32_f16(Ah[s], bh[s], ab, 0, 0, 0); ak = __builtin_amdgcn_mfma_f32_16x16x32_f16(Ah[s], kh[s], ak, 0, 0, 0);
        rb = __builtin_amdgcn_mfma_f32_16x16x32_f16(Rh[s], bh[s], rb, 0, 0, 0); rk = __builtin_amdgcn_mfma_f32_16x16x32_f16(Rh[s], kh[s], rk, 0, 0, 0);
    }
    asm volatile("s_nop 15\n\ts_nop 15" : "+v"(ab), "+v"(ak), "+v"(rb), "+v"(rk));
#pragma unroll
    for (int s = 0; s < 2; ++s) {
        *(h8*)(myb + 32 * s + 8 * q) = At8[s]; *(h8*)(myb + 64 + 32 * s + 8 * q) = Rt8[s];
        if (c == 15) *(h8*)(PCB + (((size_t)g * 2 + d) * 4 + h) * 64 + 32 * s + 8 * q) = PC8[s];
#pragma unroll
        for (int j = 0; j < 8; ++j) {
            const int cbk = 8 * s + 2 * q + (j >> 2), kk = j & 3;
            half_t* ob = blk0 + (size_t)(d ? 15 - cbk : cbk) * RWC;
            ob[128 + kk * 16 + c] = btv[8 * s + j]; ob[192 + kk * 16 + c] = ktv[8 * s + j];
        }
    }
#pragma unroll
    for (int j = 0; j < 4; ++j) {
        const int cr = 4 * q + j;
        half_t* ob = blk0 + (size_t)(d ? 15 - cr : cr) * RWC + 256 + c;
        scr[cr * 16 + c] = (half_t)(c < cr ? ab[j] : 0.f);
        ob[16] = (half_t)(c < cr ? ak[j] : 0.f); ob[32] = (half_t)(c <= cr ? rb[j] : 0.f); ob[48] = (half_t)(c <= cr ? rk[j] : 0.f);
    }
    __builtin_amdgcn_fence(__ATOMIC_RELEASE, "wavefront"); __builtin_amdgcn_wave_barrier(); __builtin_amdgcn_fence(__ATOMIC_ACQUIRE, "wavefront");
    {
        const h8 n0 = *(const h8*)(scr + c * 16), n1 = *(const h8*)(scr + c * 16 + 8);
        float t[4];
#pragma unroll
        for (int mm = 0; mm < 4; ++mm) t[mm] = (c == 4 * q + mm) ? 1.f : 0.f;
#define CP_STEP(sN, coef) do { const float cf_ = (float)(coef); _Pragma("unroll") for (int mm = 0; mm < 4; ++mm) t[mm] = fmaf(cf_, DPP_MOV_F(t[mm], 0x150 + (sN)), t[mm]); } while (0)
        CP_STEP(0, n0[0]); CP_STEP(1, n0[1]); CP_STEP(2, n0[2]); CP_STEP(3, n0[3]); CP_STEP(4, n0[4]); CP_STEP(5, n0[5]); CP_STEP(6, n0[6]); CP_STEP(7, n0[7]);
        CP_STEP(8, n1[0]); CP_STEP(9, n1[1]); CP_STEP(10, n1[2]); CP_STEP(11, n1[3]); CP_STEP(12, n1[4]); CP_STEP(13, n1[5]); CP_STEP(14, n1[6]);
#undef CP_STEP
        h4 t4;
#pragma unroll
        for (int mm = 0; mm < 4; ++mm) t4[mm] = (half_t)t[mm];
        *(h4*)(myb + 256 + 4 * q) = t4;
        __builtin_amdgcn_wave_barrier();
    }
}

DI void phase_rwprep(const Params& p, int l, unsigned char* smem) {
    const int tid = ltid(), wid = tid >> 6, lane = tid & 63;
    h2* Wp = (h2*)smem;
    half_t* svh = (half_t*)(smem + 98304) + wid * 384;
    for (int i = tid; i < 96 * 256; i += 512) {
        const int jp = i >> 8, c = i & 255; const float* src;
        if (jp < 32) { const int d = jp >> 4, j = (jp & 15) * 2; src = p.in[I_W2] + (((size_t)d * DEPTH + l) * 32 + j) * 256 + c; }
        else if (jp < 64) { const int d = (jp - 32) >> 4, j = (jp & 15) * 2; src = p.in[I_A2] + (((size_t)d * DEPTH + l) * 32 + j) * 256 + c; }
        else src = p.in[I_G2] + ((size_t)l * 64 + (jp - 64) * 2) * 256 + c;
        h2 v; v[0] = (half_t)src[0]; v[1] = (half_t)src[256];
        Wp[i] = v;
    }
    __syncthreads();
    const int c4 = lane * 4;
    float mp[3][4], mn[3][4], mpl[3], mnl[3], kkc[4], kac[4], rkc[4], w0c[2][4], a0c[2][4];
    const float* MUP = p.in[I_MUP] + l * 960; const float* MUN = p.in[I_MUN] + l * 960;
#pragma unroll
    for (int s = 0; s < 3; ++s) {
#pragma unroll
        for (int i = 0; i < 4; ++i) { mp[s][i] = MUP[s * 256 + c4 + i]; mn[s][i] = MUN[s * 256 + c4 + i]; }
        mpl[s] = MUP[768 + lane + 64 * s]; mnl[s] = MUN[768 + lane + 64 * s];
    }
#pragma unroll
    for (int i = 0; i < 4; ++i) {
        kkc[i] = p.in[I_KK][l * 256 + c4 + i]; kac[i] = p.in[I_KA][l * 256 + c4 + i]; rkc[i] = p.in[I_RK][l * 256 + c4 + i];
#pragma unroll
        for (int d = 0; d < 2; ++d) { w0c[d][i] = p.in[I_W0][(d * DEPTH + l) * 256 + c4 + i]; a0c[d][i] = p.in[I_A0][(d * DEPTH + l) * 256 + c4 + i]; }
    }
    const half_t* U = (const half_t*)(p.ws + OFF_U);
    half_t* RW = (half_t*)(p.ws + OFF_BC);
    float* CB = (float*)(p.ws + OFF_CB);
    const h4 hz = {(half_t)0, (half_t)0, (half_t)0, (half_t)0};
    h4 pz[3][4]; half_t pl[3][4];
#define RP_LOAD(gg) do { const int m0_ = (gg) * 16 + wid * 2, n0_ = m0_ % NTOK; const bool hp_ = (n0_ != 0 && n0_ != LCTX), hn_ = (n0_ + 1 != LCTX - 1 && n0_ + 1 != NTOK - 1); \
        const half_t* u0_ = U + (size_t)m0_ * UST + U_RW; \
        _Pragma("unroll") for (int s = 0; s < 3; ++s) { const int col = 768 + lane + 64 * s; \
            pz[s][0] = hp_ ? *(const h4*)(u0_ - UST + s * 256 + c4) : hz; pz[s][1] = *(const h4*)(u0_ + s * 256 + c4); pz[s][2] = *(const h4*)(u0_ + UST + s * 256 + c4); pz[s][3] = hn_ ? *(const h4*)(u0_ + 2 * UST + s * 256 + c4) : hz; \
            pl[s][0] = hp_ ? u0_[col - UST] : (half_t)0; pl[s][1] = u0_[col]; pl[s][2] = u0_[col + UST]; pl[s][3] = hn_ ? u0_[col + 2 * UST] : (half_t)0; } } while (0)
    if ((int)blockIdx.x < MROWS / 16) RP_LOAD((int)blockIdx.x);
    for (int g = blockIdx.x; g < MROWS / 16; g += gridDim.x) {
        const int m0 = g * 16 + wid * 2;
        float val[2][3][4]; float zl[3][4];
#pragma unroll
        for (int s = 0; s < 3; ++s) {
#pragma unroll
            for (int i = 0; i < 4; ++i) {
                const float xa = (float)pz[s][0][i], xb = (float)pz[s][1][i], xc = (float)pz[s][2][i], xd = (float)pz[s][3][i];
                val[0][s][i] = xb + mp[s][i] * (xa - xb) + mn[s][i] * (xc - xb);
                val[1][s][i] = xc + mp[s][i] * (xb - xc) + mn[s][i] * (xd - xc);
            }
#pragma unroll
            for (int r = 0; r < 4; ++r) zl[s][r] = (float)pl[s][r];
        }
        if (g + (int)gridDim.x < MROWS / 16) RP_LOAD(g + (int)gridDim.x);
#pragma unroll
        for (int s = 0; s < 3; ++s) {
            const float xa = zl[s][0], xb = zl[s][1], xc = zl[s][2], xd = zl[s][3];
            float z0 = xb + mpl[s] * (xa - xb) + mnl[s] * (xc - xb), z1 = xc + mpl[s] * (xb - xc) + mnl[s] * (xd - xc);
            if (s == 0) { z0 = 1.f - 2.f * __builtin_amdgcn_rcpf(1.f + __expf(2.f * z0)); z1 = 1.f - 2.f * __builtin_amdgcn_rcpf(1.f + __expf(2.f * z1)); }
            else if (s == 2) { z0 = sigmoidf_(z0); z1 = sigmoidf_(z1); }
            svh[lane + 64 * s] = (half_t)z0; svh[192 + lane + 64 * s] = (half_t)z1;
        }
        __builtin_amdgcn_fence(__ATOMIC_RELEASE, "wavefront"); __builtin_amdgcn_wave_barrier(); __builtin_amdgcn_fence(__ATOMIC_ACQUIRE, "wavefront");
        float wl[2][2][4], al[2][2][4], gt[2][4];
#pragma unroll
        for (int tt = 0; tt < 2; ++tt)
#pragma unroll
            for (int i = 0; i < 4; ++i) { wl[tt][0][i] = w0c[0][i]; wl[tt][1][i] = w0c[1][i]; al[tt][0][i] = a0c[0][i]; al[tt][1][i] = a0c[1][i]; gt[tt][i] = 0.f; }
        const h2* sv2 = (const h2*)svh;
#pragma unroll 4
        for (int jp = 0; jp < 16; ++jp) {
#pragma unroll
            for (int d = 0; d < 2; ++d) {
                const h8 w = *(const h8*)(Wp + (d * 16 + jp) * 256 + c4), a = *(const h8*)(Wp + (32 + d * 16 + jp) * 256 + c4);
#pragma unroll
                for (int tt = 0; tt < 2; ++tt) {
                    const h2 s1 = sv2[tt * 96 + d * 16 + jp], s2 = sv2[tt * 96 + 32 + d * 16 + jp];
                    wl[tt][d][0] = __builtin_amdgcn_fdot2(__builtin_shufflevector(w, w, 0, 1), s1, wl[tt][d][0], false);
                    wl[tt][d][1] = __builtin_amdgcn_fdot2(__builtin_shufflevector(w, w, 2, 3), s1, wl[tt][d][1], false);
                    wl[tt][d][2] = __builtin_amdgcn_fdot2(__builtin_shufflevector(w, w, 4, 5), s1, wl[tt][d][2], false);
                    wl[tt][d][3] = __builtin_amdgcn_fdot2(__builtin_shufflevector(w, w, 6, 7), s1, wl[tt][d][3], false);
                    al[tt][d][0] = __builtin_amdgcn_fdot2(__builtin_shufflevector(a, a, 0, 1), s2, al[tt][d][0], false);
                    al[tt][d][1] = __builtin_amdgcn_fdot2(__builtin_shufflevector(a, a, 2, 3), s2, al[tt][d][1], false);
                    al[tt][d][2] = __builtin_amdgcn_fdot2(__builtin_shufflevector(a, a, 4, 5), s2, al[tt][d][2], false);
                    al[tt][d][3] = __builtin_amdgcn_fdot2(__builtin_shufflevector(a, a, 6, 7), s2, al[tt][d][3], false);
                }
            }
        }
#pragma unroll 4
        for (int jp = 0; jp < 32; ++jp) {
            const h8 g = *(const h8*)(Wp + (64 + jp) * 256 + c4);
#pragma unroll
            for (int tt = 0; tt < 2; ++tt) {
                const h2 sg = sv2[tt * 96 + 64 + jp];
                gt[tt][0] = __builtin_amdgcn_fdot2(__builtin_shufflevector(g, g, 0, 1), sg, gt[tt][0], false);
                gt[tt][1] = __builtin_amdgcn_fdot2(__builtin_shufflevector(g, g, 2, 3), sg, gt[tt][1], false);
                gt[tt][2] = __builtin_amdgcn_fdot2(__builtin_shufflevector(g, g, 4, 5), sg, gt[tt][2], false);
                gt[tt][3] = __builtin_amdgcn_fdot2(__builtin_shufflevector(g, g, 6, 7), sg, gt[tt][3], false);
            }
        }
        __builtin_amdgcn_wave_barrier();
        const int hd = lane >> 4, kq_ = lane & 15;
#pragma unroll
        for (int tt = 0; tt < 2; ++tt) {
            float kkv[4], ssq = 0.f;
#pragma unroll
            for (int i = 0; i < 4; ++i) { kkv[i] = val[tt][1][i] * kkc[i]; ssq += kkv[i] * kkv[i]; }
            ssq = row16_sum(ssq);
            const float kn = rsqrtf(fmaxf(ssq, 1e-24f));
            half_t* rp = RW + (size_t)(m0 + tt) * RWC;
            h4 o_r, o_v, o_nkk, o_g;
#pragma unroll
            for (int i = 0; i < 4; ++i) { kkv[i] *= kn; o_r[i] = (half_t)val[tt][0][i]; o_v[i] = (half_t)val[tt][2][i]; o_nkk[i] = (half_t)(-kkv[i]); o_g[i] = (half_t)gt[tt][i]; }
            *(h4*)(rp + R_V + c4) = o_v; *(h4*)(rp + R_GATE + c4) = o_g;
            float bon = 0.f;
#pragma unroll
            for (int d = 0; d < 2; ++d) {
                h4 o_w, o_kd, o_bb;
#pragma unroll
                for (int i = 0; i < 4; ++i) {
                    const float e = 0.6065306597126334f * sigmoidf_(wl[tt][d][i]);
                    const float omw = 1.f - __expf(-e);
                    const float a = sigmoidf_(al[tt][d][i]);
                    const float kd = val[tt][1][i] * (1.f + (a - 1.f) * kac[i]);
                    o_w[i] = (half_t)(-omw); o_kd[i] = (half_t)kd; o_bb[i] = (half_t)(kkv[i] * a);
                    bon += val[tt][0][i] * kd * rkc[i];
                }
                half_t* bp = rp + (d * 4 + hd) * 320;
                const h8 pa = __builtin_shufflevector(o_nkk, o_w, 0, 1, 2, 3, 4, 5, 6, 7), pb = __builtin_shufflevector(o_bb, o_kd, 0, 1, 2, 3, 4, 5, 6, 7);
                *(h8*)(bp + kq_ * 8) = pa; *(h8*)(bp + 128 + kq_ * 8) = pb; *(h4*)(bp + 256 + kq_ * 4) = o_r;
            }
            bon = row16_sum(bon);
            if ((lane & 15) == 0) CB[(size_t)(m0 + tt) * 4 + (lane >> 4)] = bon;
        }
    }
    __syncthreads();
    {
        const int tid2 = ltid();
#pragma unroll 1
        for (int g = blockIdx.x; g < MROWS / 16; g += gridDim.x) rw_chunkprep((half_t*)(p.ws + OFF_BC), (half_t*)(p.ws + OFF_PCB), g, tid2 >> 6, tid2 & 63, (half_t*)(smem + 98304) + (tid2 >> 6) * 384);
    }
}

constexpr int SC_CH = 32, SC_RWSTEP = 672, SC_HGOFF = SC_CH * SC_RWSTEP, SC_HGSTEP = 288, SC_PCOFF = SC_HGOFF + SC_CH * SC_HGSTEP, SC_NPIECE = 1936, SC_BUF = 2240 * 16, SC_OPS = 3 * SC_BUF, SC_JOB = 5760;
DI void phase_scan(const Params& p, int l, unsigned char* smem) {
    const int tid = ltid(), wid = tid >> 6, lane = tid & 63, grp = lane >> 4, kq = lane & 15;
    half_t* U = (half_t*)(p.ws + OFF_U);
    const half_t* RW = (const half_t*)(p.ws + OFF_BC);
    for (int job = blockIdx.x; job < 256; job += gridDim.x) {
        const int s = (gridDim.x == 256) ? (job & 7) + 8 * (job >> 5) : job >> 2, quarter = (gridDim.x == 256) ? (job >> 3) & 3 : job & 3, b = s >> 3, h = (s >> 1) & 3, d = s & 1, sgn = d ? -1 : 1;
        const size_t rowb = (size_t)b * NTOK;
        const half_t* PCB = (const half_t*)(p.ws + OFF_PCB);
        const int lrank = (wid == 1) ? 0 : (wid == 3) ? 1 : wid - 3;
        const bool is_ld = (wid == 1 || wid == 3 || wid >= 5);
        const int lt = lrank * 64 + lane;
        unsigned l_base[7]; int l_strb[7];
#pragma unroll
        for (int j = 0; j < 7; ++j) {
            const int pc = lt + 320 * j; size_t off; int i, strb;
            if (pc < 1344) { i = pc / 42; const int w = pc - i * 42; strb = RWC * 2;
                off = OFF_BC + ((w < 40) ? rowb * RWC + (d * 4 + h) * 320 + w * 8 : rowb * RWC + R_V + h * 64 + quarter * 16 + (w - 40) * 8) * 2; }
            else if (pc < 1920) { const int p2 = pc - 1344; i = p2 / 18; const int w = p2 - i * 18; strb = UST * 2;
                off = OFF_U + ((w < 8) ? rowb * UST + U_HGKF + d * 256 + h * 64 + w * 8 : (w < 16) ? rowb * UST + U_HGQ + h * 64 + (w - 8) * 8 : rowb * UST + U_HGI + h * 64 + quarter * 16 + (w - 16) * 8) * 2; }
            else { const int pp = (pc < SC_NPIECE) ? pc - 1920 : 0, j2 = pp >> 3, part = pp & 7;
                i = d ? 16 * j2 + 15 : 16 * j2; strb = 64;
                off = OFF_PCB + ((rowb >> 4) * 512 + (d * 4 + h) * 64 + part * 8) * 2; }
            l_base[j] = (unsigned)((long long)off + (long long)(sgn * i) * strb); l_strb[j] = strb;
        }
        auto chunk_tok0 = [&](int ch) -> int {
            const int seg = ch >= LCTX / SC_CH, t = seg ? (ch - LCTX / SC_CH) * SC_CH : ch * SC_CH;
            const int tok0 = d ? (seg ? NTOK - 1 : LCTX - 1) : (seg ? LCTX : 0);
            return tok0 + sgn * t; };
        LAS unsigned char* lds0 = (LAS unsigned char*)smem;
#define SC_DMA(ch, bi) do { const int t0_ = chunk_tok0(ch); _Pragma("unroll") for (int j = 0; j < 7; ++j) \
            __builtin_amdgcn_global_load_lds((const unsigned*)(p.ws + (size_t)(l_base[j] + (unsigned)(t0_ * l_strb[j]))), (LAS unsigned*)(lds0 + (bi) * SC_BUF + (lrank * 64 + 320 * j) * 16), 16, 0, 0); } while (0)
        constexpr int NCH = NTOK / SC_CH;
        if (is_ld) { SC_DMA(0, 0); SC_DMA(1, 1); }
        f32x4 St[4];
#pragma unroll
        for (int kt = 0; kt < 4; ++kt) St[kt] = (f32x4){0.f, 0.f, 0.f, 0.f};
        const int rr = ((wid & 3) * 4 + grp);
        half_t* obase = (wid < 4) ? U + rowb * UST + U_YF + d * 256 + h * 64 + quarter * 16 + rr : U + rowb * UST + U_OF + d * 256 + h * 64 + quarter * 16 + rr;
        f32x4 Sh[4];
#pragma unroll
        for (int kt = 0; kt < 4; ++kt) Sh[kt] = (f32x4){0.f, 0.f, 0.f, 0.f};
        int bcur = 0;
#pragma unroll 1
        for (int ch = 0; ch <= NCH; ++ch) {
            if (is_ld) { if (ch + 1 >= NCH) asm volatile("s_waitcnt vmcnt(0)" ::: "memory"); else asm volatile("s_waitcnt vmcnt(7)" ::: "memory"); }
            asm volatile("s_waitcnt lgkmcnt(0)" ::: "memory"); __builtin_amdgcn_s_barrier(); asm volatile("" ::: "memory");
            const int bnxt2 = (bcur == 0) ? 2 : bcur - 1;
            if (is_ld && ch + 2 < NCH) SC_DMA(ch + 2, bnxt2);
            const unsigned char* bufp = smem + bcur * SC_BUF;
            bcur = (bcur == 2) ? 0 : bcur + 1;
            const int tokc = chunk_tok0(ch < NCH ? ch : NCH - 1);
            {
                if (wid == 0 && ch < NCH) {
                    const int x = lane & 15, q = lane >> 4;
#pragma unroll 1
                    for (int j2 = 0; j2 < 2; ++j2) {
                        const unsigned char* cb = bufp + (16 * j2) * SC_RWSTEP;
                        const unsigned char* mb = cb + x * SC_RWSTEP;
                        const half_t* pcb = (const half_t*)(bufp + SC_PCOFF + j2 * 128);
                        h8 atf[2], rtf[2], bkf[4]; h4 pcf[4];
#pragma unroll
                        for (int sI = 0; sI < 2; ++sI) {
                            const h4 lo = *(const h4*)(mb + (32 * sI + 4 * q) * 2), hi = *(const h4*)(mb + (32 * sI + 16 + 4 * q) * 2);
                            atf[sI] = __builtin_shufflevector(lo, hi, 0, 1, 2, 3, 4, 5, 6, 7);
                            const h4 lo2 = *(const h4*)(mb + (64 + 32 * sI + 4 * q) * 2), hi2 = *(const h4*)(mb + (64 + 32 * sI + 16 + 4 * q) * 2);
                            rtf[sI] = __builtin_shufflevector(lo2, hi2, 0, 1, 2, 3, 4, 5, 6, 7);
                        }
                        h4 Vf;
#pragma unroll
                        for (int j = 0; j < 4; ++j) Vf[j] = *(const half_t*)(cb + (4 * q + j) * SC_RWSTEP + 640 + x * 2);
                        const h4 akf = *(const h4*)(mb + (272 + 4 * q) * 2);
                        const h4 tfr = *(const h4*)(mb + (256 + 4 * q) * 2);
                        const h4 arb = *(const h4*)(mb + (288 + 4 * q) * 2), ark = *(const h4*)(mb + (304 + 4 * q) * 2);
#pragma unroll
                        for (int kt = 0; kt < 4; ++kt) {
                            const unsigned char* kb2 = cb + (4 * kt + (x >> 2)) * SC_RWSTEP;
                            const h4 bt = *(const h4*)(kb2 + (128 + (x & 3) * 16 + 4 * q) * 2), ktt = *(const h4*)(kb2 + (192 + (x & 3) * 16 + 4 * q) * 2);
                            bkf[kt] = __builtin_shufflevector(bt, ktt, 0, 1, 2, 3, 4, 5, 6, 7);
                            pcf[kt] = *(const h4*)(pcb + 16 * kt + 4 * q);
                        }
                        h8 Sf[2];
#pragma unroll
                        for (int sI = 0; sI < 2; ++sI)
#pragma unroll
                            for (int j = 0; j < 4; ++j) { Sf[sI][j] = (half_t)St[2 * sI][j]; Sf[sI][4 + j] = (half_t)St[2 * sI + 1][j]; }
                        f32x4 XT = {0.f, 0.f, 0.f, 0.f};
#pragma unroll
                        for (int sI = 0; sI < 2; ++sI) XT = __builtin_amdgcn_mfma_f32_16x16x32_f16(atf[sI], Sf[sI], XT, 0, 0, 0);
                        XT = __builtin_amdgcn_mfma_f32_16x16x16f16(akf, Vf, XT, 0, 0, 0);
                        asm volatile("s_nop 15\n\ts_nop 15" : "+v"(XT));
#pragma unroll
                        for (int kt = 0; kt < 4; ++kt)
#pragma unroll
                            for (int j = 0; j < 4; ++j) St[kt][j] *= (float)pcf[kt][j];
                        f32x4 Yv = {0.f, 0.f, 0.f, 0.f};
#pragma unroll
                        for (int sI = 0; sI < 2; ++sI) Yv = __builtin_amdgcn_mfma_f32_16x16x32_f16(rtf[sI], Sf[sI], Yv, 0, 0, 0);
                        h8 UV;
                        { h4 xh;
#pragma unroll
                          for (int j = 0; j < 4; ++j) xh[j] = (half_t)XT[j];
                          f32x4 Uc = {0.f, 0.f, 0.f, 0.f};
                          Uc = __builtin_amdgcn_mfma_f32_16x16x16f16(tfr, xh, Uc, 0, 0, 0);
                          asm volatile("s_nop 15\n\ts_nop 15" : "+v"(Uc));
#pragma unroll
                          for (int j = 0; j < 4; ++j) { UV[j] = (half_t)Uc[j]; UV[4 + j] = Vf[j]; } }
                        Yv = __builtin_amdgcn_mfma_f32_16x16x32_f16(__builtin_shufflevector(arb, ark, 0, 1, 2, 3, 4, 5, 6, 7), UV, Yv, 0, 0, 0);
                        asm volatile("s_nop 15\n\ts_nop 15" : "+v"(Yv));
                        { half_t* yb = U + rowb * UST + U_YF + d * 256 + h * 64 + quarter * 16 + x;
#pragma unroll
                          for (int j = 0; j < 4; ++j) yb[(ptrdiff_t)(tokc + sgn * (16 * j2 + 4 * q + j)) * UST] = (half_t)Yv[j]; }
#pragma unroll
                        for (int kt = 0; kt < 4; ++kt) St[kt] = __builtin_amdgcn_mfma_f32_16x16x32_f16(bkf[kt], UV, St[kt], 0, 0, 0);
                        asm volatile("s_nop 15\n\ts_nop 15" : "+v"(St[0]), "+v"(St[1]), "+v"(St[2]), "+v"(St[3]));
                    }
                }
                if ((wid == 3 || wid >= 5) && ch < NCH) {
                    const int pw = (wid == 3) ? 3 : wid - 5, j2 = pw >> 1, sI = pw & 1, c = lane & 15, q = lane >> 4;
                    const unsigned char* hb = bufp + SC_HGOFF + (16 * j2 + c) * SC_HGSTEP;
                    unsigned char* ob = smem + SC_OPS + ((ch & 1) * 2 + j2) * SC_JOB;
                    f32x4 aq = {0.f, 0.f, 0.f, 0.f};
                    {
                        const h8 kf8 = *(const h8*)(hb + (32 * sI + 8 * q) * 2), q8 = *(const h8*)(hb + 128 + (32 * sI + 8 * q) * 2);
                        h8 qt8, pc8;
#pragma unroll
                        for (int j = 0; j < 8; ++j) {
                            const float kfv = (float)kf8[j], qv = (float)q8[j];
                            float bsum = fmaxf(__builtin_amdgcn_logf(1.f - kfv) * 0.6931471805599453f, -80.f);
                            bsum += DPP_SHR_ZERO(bsum, 0x111); bsum += DPP_SHR_ZERO(bsum, 0x112); bsum += DPP_SHR_ZERO(bsum, 0x114); bsum += DPP_SHR_ZERO(bsum, 0x118);
                            const float bC = DPP_MOV_F(bsum, 0x15F), bm = DPP_MOV_F(bsum, 0x157);
                            float eb = __expf(bsum);
                            asm volatile("s_nop 1" : "+v"(eb));
                            qt8[j] = (half_t)(qv * eb); pc8[j] = (half_t)DPP_MOV_F(eb, 0x15F);
                            *(half_t*)(ob + 2048 + ((32 * sI + 8 * q + j) * 16 + c) * 2) = (half_t)(kfv * __expf(bC - bsum));
                            const float em = __expf(fminf(fmaxf(bsum - bm, -60.f), 60.f));
                            const float qh = qv * em, kh = kfv * __builtin_amdgcn_rcpf(em);
                            aq = __builtin_amdgcn_mfma_f32_16x16x4f32(qh, kh, aq, 0, 0, 0);
                        }
                        *(h8*)(ob + (c * 64 + 32 * sI + 8 * q) * 2) = qt8;
                        if (c == 15) *(h8*)(ob + 4608 + (32 * sI + 8 * q) * 2) = pc8;
                    }
                    asm volatile("s_nop 15\n\ts_nop 15" : "+v"(aq));
#pragma unroll
                    for (int j = 0; j < 4; ++j) { const int cr = 4 * q + j; *(half_t*)(ob + (sI ? 5248 : 4096) + (cr * 16 + c) * 2) = (half_t)(c <= cr ? aq[j] : 0.f); }
                    if (sI == 0) *(h4*)(ob + 4736 + (lane >> 2) * 32 + (lane & 3) * 8) = *(const h4*)(bufp + SC_HGOFF + (16 * j2 + (lane >> 2)) * SC_HGSTEP + 256 + (lane & 3) * 8);
                }
                if (wid == 2 && ch >= 1) {
                    const int x = lane & 15, q = lane >> 4, tokp = chunk_tok0(ch - 1);
#pragma unroll 1
                    for (int j2 = 0; j2 < 2; ++j2) {
                        const unsigned char* ob = smem + SC_OPS + (((ch - 1) & 1) * 2 + j2) * SC_JOB;
                        h8 Sf[2];
#pragma unroll
                        for (int sI = 0; sI < 2; ++sI)
#pragma unroll
                            for (int j = 0; j < 4; ++j) { Sf[sI][j] = (half_t)Sh[2 * sI][j]; Sf[sI][4 + j] = (half_t)Sh[2 * sI + 1][j]; }
                        f32x4 Yv = {0.f, 0.f, 0.f, 0.f};
#pragma unroll
                        for (int sI = 0; sI < 2; ++sI) {
                            const h4 lo = *(const h4*)(ob + (x * 64 + 32 * sI + 4 * q) * 2), hi = *(const h4*)(ob + (x * 64 + 32 * sI + 16 + 4 * q) * 2);
                            Yv = __builtin_amdgcn_mfma_f32_16x16x32_f16(__builtin_shufflevector(lo, hi, 0, 1, 2, 3, 4, 5, 6, 7), Sf[sI], Yv, 0, 0, 0);
                        }
                        h4 Vf;
#pragma unroll
                        for (int j = 0; j < 4; ++j) Vf[j] = *(const half_t*)(ob + 4736 + ((4 * q + j) * 16 + x) * 2);
                        { const h4 aqf = *(const h4*)(ob + 4096 + (x * 16 + 4 * q) * 2), aqg = *(const h4*)(ob + 5248 + (x * 16 + 4 * q) * 2);
                          Yv = __builtin_amdgcn_mfma_f32_16x16x16f16(aqf, Vf, Yv, 0, 0, 0); Yv = __builtin_amdgcn_mfma_f32_16x16x16f16(aqg, Vf, Yv, 0, 0, 0); }
                        asm volatile("s_nop 15\n\ts_nop 15" : "+v"(Yv));
                        { half_t* yb = U + rowb * UST + U_OF + d * 256 + h * 64 + quarter * 16 + x;
#pragma unroll
                          for (int j = 0; j < 4; ++j) yb[(ptrdiff_t)(tokp + sgn * (16 * j2 + 4 * q + j)) * UST] = (half_t)Yv[j]; }
#pragma unroll
                        for (int kt = 0; kt < 4; ++kt) {
                            const h4 kt4 = *(const h4*)(ob + 2048 + ((16 * kt + x) * 16 + 4 * q) * 2), pc = *(const h4*)(ob + 4608 + (16 * kt + 4 * q) * 2);
                            f32x4 sc = Sh[kt];
#pragma unroll
                            for (int j = 0; j < 4; ++j) sc[j] *= (float)pc[j];
                            Sh[kt] = __builtin_amdgcn_mfma_f32_16x16x16f16(kt4, Vf, sc, 0, 0, 0);
                        }
                        asm volatile("s_nop 15\n\ts_nop 15" : "+v"(Sh[0]), "+v"(Sh[1]), "+v"(Sh[2]), "+v"(Sh[3]));
                    }
                }
            }
        }
        __syncthreads();
#undef SC_DMA
    }
}

DI void attn_item(const Params& p, int l, int item, unsigned char* smem, float lam, float lam_init) {
    const int tid = ltid(), wid = tid >> 6, lane = tid & 63;
    int b, h, n0, nkt;
    if (item < 512) { b = item >> 6; h = (item >> 4) & 3; n0 = LCTX + (item & 15) * 256; nkt = NTOK / 64; }
    else { const int i2 = item - 512; b = i2 >> 2; h = i2 & 3; n0 = 0; nkt = LCTX / 64; }
    half_t* U = (half_t*)(p.ws + OFF_U);
    const size_t rowb = (size_t)b * NTOK;
    const int q = lane & 31, hh = lane >> 5, qq = (lane & 15) >> 2, pp = lane & 3, blk = (lane >> 4) & 1;
    half_t* qrow = U + (rowb + n0 + wid * 32 + q) * UST + U_DAQ + h * 128;
    const int kkey = tid >> 3, kch = tid & 7, vkey = tid >> 4, vch = tid & 15;
    h2 o0p[32];
    f32x16 O[4];
    float inv = 0.f;
    for (int mp = 0; mp < 2; ++mp) {
        h8 qf[4];
#pragma unroll
        for (int s = 0; s < 4; ++s) qf[s] = *(const h8*)(qrow + mp * 64 + 16 * s + 8 * hh);
#pragma unroll
        for (int t = 0; t < 4; ++t)
#pragma unroll
            for (int i = 0; i < 16; ++i) O[t][i] = 0.f;
        float l_part = 0.f;
        f32x16 NEGM;
#pragma unroll
        for (int i = 0; i < 16; ++i) NEGM[i] = 0.f;
        const half_t* kg = U + (rowb + kkey) * UST + U_DAK + h * 128 + mp * 64 + kch * 8;
        const half_t* vg = U + (rowb + vkey) * UST + U_DAV + h * 128 + vch * 8;
        h8 kreg = *(const h8*)kg, vreg0 = *(const h8*)vg, vreg1 = *(const h8*)(vg + (size_t)32 * UST);
        for (int kt = 0; kt < nkt; ++kt) {
            unsigned char* Kc = smem + (kt & 1) * 9216; unsigned char* Vc = smem + 18432 + (kt & 1) * 18432;
            *(h8*)(Kc + kkey * 144 + kch * 16) = kreg;
            *(h8*)(Vc + vkey * 288 + vch * 16) = vreg0; *(h8*)(Vc + (vkey + 32) * 288 + vch * 16) = vreg1;
            __syncthreads();
            if (kt + 1 < nkt) { const size_t adv = (size_t)(kt + 1) * 64 * UST; kreg = *(const h8*)(kg + adv); vreg0 = *(const h8*)(vg + adv); vreg1 = *(const h8*)(vg + adv + (size_t)32 * UST); }
            f32x16 S0 = NEGM, S1 = NEGM;
#pragma unroll
            for (int s = 0; s < 4; ++s) {
                const h8 k0 = *(const h8*)(Kc + q * 144 + (16 * s + 8 * hh) * 2);
                const h8 k1 = *(const h8*)(Kc + (32 + q) * 144 + (16 * s + 8 * hh) * 2);
                S0 = __builtin_amdgcn_mfma_f32_32x32x16_f16(k0, qf[s], S0, 0, 0, 0);
                S1 = __builtin_amdgcn_mfma_f32_32x32x16_f16(k1, qf[s], S1, 0, 0, 0);
            }
            asm volatile("s_nop 15\n\ts_nop 15" : "+v"(S0), "+v"(S1));
            float mx = S0[0];
#pragma unroll
            for (int i = 1; i < 16; ++i) mx = fmaxf(mx, S0[i]);
#pragma unroll
            for (int i = 0; i < 16; ++i) mx = fmaxf(mx, S1[i]);
            if (kt == 0 || __any(mx > 6.f)) {
                mx = fmaxf(mx, __shfl_xor(mx, 32));
                const float dlt = (kt == 0) ? mx : fmaxf(mx, 0.f);
                const float alpha = (kt == 0) ? 0.f : __builtin_amdgcn_exp2f(-dlt);
                l_part *= alpha;
#pragma unroll
                for (int t = 0; t < 4; ++t)
#pragma unroll
                    for (int i = 0; i < 16; ++i) O[t][i] *= alpha;
#pragma unroll
                for (int i = 0; i < 16; ++i) { S0[i] -= dlt; S1[i] -= dlt; NEGM[i] -= dlt; }
            }
            float ps = 0.f;
#pragma unroll
            for (int i = 0; i < 16; ++i) { S0[i] = __builtin_amdgcn_exp2f(S0[i]); S1[i] = __builtin_amdgcn_exp2f(S1[i]); ps += S0[i] + S1[i]; }
            l_part += ps;
#pragma unroll
            for (int kb = 0; kb < 2; ++kb)
#pragma unroll
                for (int s2 = 0; s2 < 2; ++s2) {
                    h8 pf;
#pragma unroll
                    for (int j = 0; j < 8; ++j) pf[j] = (half_t)(kb ? S1[8 * s2 + j] : S0[8 * s2 + j]);
                    const unsigned char* vb = Vc + (kb * 32 + 16 * s2 + 4 * hh + qq) * 288 + 8 * (4 * blk + pp);
#pragma unroll
                    for (int t = 0; t < 4; ++t) {
                        const s4v lo = __builtin_amdgcn_ds_read_tr16_b64_v4i16((LAS s4v*)(vb + t * 64));
                        const s4v hi = __builtin_amdgcn_ds_read_tr16_b64_v4i16((LAS s4v*)(vb + 8 * 288 + t * 64));
                        const h4 lo4 = __builtin_bit_cast(h4, lo), hi4 = __builtin_bit_cast(h4, hi);
                        const h8 vf = __builtin_shufflevector(lo4, hi4, 0, 1, 2, 3, 4, 5, 6, 7);
                        O[t] = __builtin_amdgcn_mfma_f32_32x32x16_f16(vf, pf, O[t], 0, 0, 0);
                    }
                }
        }
        __syncthreads();
        const float lsum = l_part + __shfl_xor(l_part, 32);
        inv = 1.f / lsum;
        if (mp == 0) {
#pragma unroll
            for (int t = 0; t < 4; ++t)
#pragma unroll
                for (int i = 0; i < 8; ++i) { h2 v; v[0] = (half_t)(O[t][2 * i] * inv); v[1] = (half_t)(O[t][2 * i + 1] * inv); o0p[t * 8 + i] = v; }
        }
    }
    float ssq = 0.f;
    const float li = lam * inv;
#pragma unroll
    for (int t = 0; t < 4; ++t)
#pragma unroll
        for (int i = 0; i < 16; ++i) { const float of = (float)o0p[t * 8 + (i >> 1)][i & 1] - li * O[t][i]; O[t][i] = of; ssq += of * of; }
    ssq += __shfl_xor(ssq, 32);
    const float rs = rsqrtf(ssq * (1.f / 128.f) + 1e-6f) * (1.f - lam_init);
    const float* ng = p.in[I_DANG] + l * 128;
#pragma unroll
    for (int t = 0; t < 4; ++t)
#pragma unroll
        for (int g4 = 0; g4 < 4; ++g4) {
            const int dv0 = t * 32 + 8 * g4 + 4 * hh;
            const f32x4 gg = *(const f32x4*)(ng + dv0);
            h4 o;
#pragma unroll
            for (int j = 0; j < 4; ++j) o[j] = (half_t)(O[t][4 * g4 + j] * rs * gg[j]);
            *(h4*)(qrow + dv0) = o;
        }
}
DI void phase_attn(const Params& p, int l, unsigned char* smem) {
    const float* LAM = (const float*)(p.ws + OFF_LAM);
    const float lam = LAM[l], lam_init = LAM[4 + l];
    if (gridDim.x == 256) {
        const int c = (int)blockIdx.x, x = c & 7, slot = c >> 3;
#pragma unroll 1
        for (int r = 0; r < 2; ++r) { const int bh = x + 8 * (2 * r + (slot >> 4)); attn_item(p, l, bh * 16 + (slot & 15), smem, lam, lam_init); }
        if (slot < 4 && l + 1 < DEPTH) attn_item(p, l, 512 + x + 8 * slot, smem, lam, lam_init);
    } else {
        for (int item = blockIdx.x; item < 544; item += gridDim.x) attn_item(p, l, item, smem, lam, lam_init);
    }
}

DI void phase_post(const Params& p, int l) {
    const int tid_ = ltid(), wid = tid_ >> 6, lane = tid_ & 63, c4 = lane * 4;
    half_t* U = (half_t*)(p.ws + OFF_U);
    const half_t* RW = (const half_t*)(p.ws + OFF_BC);
    const float* CB = (const float*)(p.ws + OFF_CB);
    float hgn[4], lnw[4], lnb[4];
#pragma unroll
    for (int i = 0; i < 4; ++i) { hgn[i] = p.in[I_HGNG][l * 64 + ((c4 + i) & 63)]; lnw[i] = p.in[I_LNW][l * 256 + c4 + i]; lnb[i] = p.in[I_LNB][l * 256 + c4 + i]; }
    for (int m = blockIdx.x * 8 + wid; m < MROWS; m += gridDim.x * 8) {
        if (l == DEPTH - 1 && (m % NTOK) < LCTX) continue;
        half_t* ur = U + (size_t)m * UST;
        { const h4 of = *(const h4*)(ur + U_OF + c4), ob = *(const h4*)(ur + U_OF + 256 + c4), sg = *(const h4*)(ur + U_HGG + c4);
          float o[4], ss = 0.f;
#pragma unroll
          for (int i = 0; i < 4; ++i) { o[i] = (float)of[i] + (float)ob[i]; ss += o[i] * o[i]; }
          ss = row16_sum(ss);
          const float rstd = rsqrtf(ss * (1.f / 64.f) + 1e-6f);
          h4 r;
#pragma unroll
          for (int i = 0; i < 4; ++i) r[i] = (half_t)(o[i] * rstd * hgn[i] * (float)sg[i]);
          *(h4*)(ur + U_MIX + c4) = r; }
        { const h4 yf = *(const h4*)(ur + U_YF + c4), yb = *(const h4*)(ur + U_YF + 256 + c4);
          const half_t* rp = RW + (size_t)m * RWC;
          const h4 vv = *(const h4*)(rp + R_V + c4), gt = *(const h4*)(rp + R_GATE + c4);
          const float bon = CB[(size_t)m * 4 + (lane >> 4)];
          float y[4], s1 = 0.f;
#pragma unroll
          for (int i = 0; i < 4; ++i) { y[i] = (float)yf[i] + (float)yb[i]; s1 += y[i]; }
          s1 = row16_sum(s1);
          const float mean = s1 * (1.f / 64.f);
          float s2 = 0.f;
#pragma unroll
          for (int i = 0; i < 4; ++i) { y[i] -= mean; s2 += y[i] * y[i]; }
          s2 = row16_sum(s2);
          const float rstd = rsqrtf(s2 * (1.f / 64.f) + 64e-5f);
          h4 r;
#pragma unroll
          for (int i = 0; i < 4; ++i) r[i] = (half_t)((y[i] * rstd * lnw[i] + lnb[i] + bon * (float)vv[i]) * (float)gt[i]);
          *(h4*)(ur + U_MIXRW + c4) = r; }
    }
}

DI void phase_final(const Params& p) {
    const int tid_ = ltid(), wid = tid_ >> 6, lane = tid_ & 63;
    const float* gn = p.in[I_FNG];
    for (int m0 = (blockIdx.x * 8 + wid) * 2; m0 < NB * TLAT; m0 += gridDim.x * 16) {
        f32x4 v[2][4]; float ss[2];
#pragma unroll
        for (int r = 0; r < 2; ++r)
#pragma unroll
            for (int i = 0; i < 4; ++i) v[r][i] = *(const f32x4*)(p.out + (size_t)(m0 + r) * DM + i * 256 + lane * 4);
#pragma unroll
        for (int r = 0; r < 2; ++r) {
            float a = 0.f;
#pragma unroll
            for (int i = 0; i < 4; ++i) a += v[r][i][0] * v[r][i][0] + v[r][i][1] * v[r][i][1] + v[r][i][2] * v[r][i][2] + v[r][i][3] * v[r][i][3];
            ss[r] = wave_sum(a);
        }
#pragma unroll
        for (int r = 0; r < 2; ++r) {
            const float rstd = rsqrtf(ss[r] * (1.f / DM) + 1e-6f);
#pragma unroll
            for (int i = 0; i < 4; ++i) { const int c = i * 256 + lane * 4; const f32x4 g = *(const f32x4*)(gn + c); *(f32x4*)(p.out + (size_t)(m0 + r) * DM + c) = v[r][i] * rstd * g; }
        }
    }
}

#define XB_TMO      128
#define XB_XCNT(j)  (256  + 64 * (j))
#define XB_XSUB(j)  (1280 + 64 * (j))
#define XB_XGEN(j)  (2304 + 64 * (j))
#define XB_TOP      3328
#define XB_TOPGEN   3392
#define XCD_BAR_WORDS 3456
#define XB_SPIN_CAP (1u << 22)

__device__ __forceinline__ unsigned xb_ld(unsigned* p)              { return __hip_atomic_load(p, __ATOMIC_RELAXED, __HIP_MEMORY_SCOPE_AGENT); }
__device__ __forceinline__ unsigned xb_add(unsigned* p, unsigned v) { return __hip_atomic_fetch_add(p, v, __ATOMIC_RELAXED, __HIP_MEMORY_SCOPE_AGENT); }
__device__ __forceinline__ unsigned xb_xcc_id() { return (unsigned)__builtin_amdgcn_s_getreg((3 << 11) | 20) & 0xFu; }
#define XB_SPIN(cond, bar) do { unsigned _sp = 0; while (cond) { __builtin_amdgcn_s_sleep(1); \
    if ((++_sp & 255u) == 0u) { if (xb_ld(&(bar)[XB_TMO])) break; if (_sp > XB_SPIN_CAP) { atomicAdd(&(bar)[XB_TMO], 1u); break; } } } } while (0)

struct XcdBarrier {
    unsigned* bar; unsigned x;
    volatile LAS unsigned* st;
};

__device__ __forceinline__ XcdBarrier xcd_barrier_post(unsigned* bar, volatile LAS unsigned* st) {
    XcdBarrier b; b.bar = bar; b.x = xb_xcc_id(); b.st = st;
    if (threadIdx.x == 0) (void)xb_add(&bar[XB_XCNT(b.x)], 1u);
    return b;
}
__device__ __forceinline__ void xcd_barrier_complete(unsigned* bar, unsigned x, unsigned& nloc, unsigned& nx) {
    const unsigned G = gridDim.x * gridDim.y * gridDim.z;
    unsigned sum, cnt, mine, sp = 0u;
    for (;;) {
        sum = 0u; cnt = 0u; mine = 0u;
#pragma unroll
        for (unsigned j = 0; j < 16; ++j) { const unsigned c = xb_ld(&bar[XB_XCNT(j)]); sum += c; cnt += (c > 0u) ? 1u : 0u; mine = (j == x) ? c : mine; }
        if (sum == G) break;
        __builtin_amdgcn_s_sleep(1);
        if ((++sp & 255u) == 0u) { if (xb_ld(&bar[XB_TMO])) break; if (sp > XB_SPIN_CAP) { atomicAdd(&bar[XB_TMO], 1u); break; } }
    }
    nloc = mine > 0u ? mine : 1u; nx = cnt > 0u ? cnt : 1u;
}

__device__ __forceinline__ void xcd_barrier(const XcdBarrier& b) {
    asm volatile("s_waitcnt vmcnt(0)" ::: "memory");
    __syncthreads();
    if (threadIdx.x == 0) {
        unsigned* bar = b.bar;
        __builtin_amdgcn_s_waitcnt(0);
        unsigned nloc = b.st[0], nx = b.st[1];
        if (nloc == 0u) { xcd_barrier_complete(bar, b.x, nloc, nx); b.st[0] = nloc; b.st[1] = nx; }
        const unsigned old = xb_add(&bar[XB_XSUB(b.x)], 1u);
        const unsigned gen = old / nloc;
        if (old + 1u == (gen + 1u) * nloc) {
            __builtin_amdgcn_fence(__ATOMIC_RELEASE, "agent");
            asm volatile("s_waitcnt vmcnt(0)" ::: "memory");
            const unsigned og = xb_add(&bar[XB_TOP], 1u);
            const unsigned tg = og / nx;
            if (og + 1u == (tg + 1u) * nx) xb_add(&bar[XB_TOPGEN], 1u);
            else XB_SPIN(xb_ld(&bar[XB_TOPGEN]) == tg, bar);
            __builtin_amdgcn_fence(__ATOMIC_ACQUIRE, "agent");
            xb_add(&bar[XB_XGEN(b.x)], 1u);
            asm volatile("s_waitcnt vmcnt(0)" ::: "memory");
        } else {
            XB_SPIN(xb_ld(&bar[XB_XGEN(b.x)]) == gen, bar);
            __builtin_amdgcn_fence(__ATOMIC_ACQUIRE, "agent");
            asm volatile("s_waitcnt vmcnt(0)" ::: "memory");
        }
    }
    __syncthreads();
}


__global__ void __launch_bounds__(512, 2) fwd_megakernel(Params p) {
    extern __shared__ __attribute__((aligned(16))) unsigned char smem[];
    cg::grid_group grid = cg::this_grid();
    pg8::StaticOrder S;
    __shared__ uint4 xb_words;
    unsigned* bar = (unsigned*)(p.ws + OFF_BAR);
    if (threadIdx.x == 0) xb_words = make_uint4(0u, 0u, 0u, 0u);
    if (blockIdx.x == 0) for (int i = threadIdx.x; i < XCD_BAR_WORDS; i += 512) bar[i] = 0u;
    phase_prologue(p, smem);
    __syncthreads();
    phase_convert(p, 0, smem);
    grid.sync();
    const XcdBarrier xb = xcd_barrier_post(bar, (volatile LAS unsigned*)&xb_words);
#pragma unroll 1
    for (int l_ = 0; l_ < DEPTH; ++l_) {
        int l = l_; asm volatile("" : "+s"(l));
        const float* MODl = (const float*)(p.ws + OFF_MOD) + (size_t)l * 9 * 6144;
        float* XC = (float*)(p.ws + OFF_XC);
        if (l > 0) phase_convert(p, l, smem);
        phase_norm(p, l, 0);
        xcd_barrier(xb);
        { pg8::Gemm g{(const half_t*)(p.ws + OFF_BC), (const half_t*)(p.ws + OFF_WIN), MROWS, UST, DM, DM, 0};
          S.init(g.M, g.N, (int)gridDim.x, (int)blockIdx.x);
          EpiIn E{(half_t*)(p.ws + OFF_U), (const float*)(p.ws + OFF_LB) + l * 512, (const float*)(p.ws + OFF_ROPE)};
          pg8::gemm_phase(( LAS unsigned char*)smem, g, S, E); }
        xcd_barrier(xb);
        phase_rwprep(p, l, smem);
        xcd_barrier(xb);
        phase_scan(p, l, smem);
        phase_attn(p, l, smem);
        xcd_barrier(xb);
        phase_post(p, l);
        xcd_barrier(xb);
        { pg8::Gemm g{(const half_t*)(p.ws + OFF_U) + U_MIX, (const half_t*)(p.ws + OFF_WOUT), MROWS, DM, DM, UST, 0};
          S.init(g.M, g.N, (int)gridDim.x, (int)blockIdx.x, l == DEPTH - 1);
          EpiRes E{l == 0 ? p.in[I_X] : (const float*)p.out, l == 0 ? p.in[I_CTX] : (const float*)XC, p.out, XC, MODl + 2048};
          pg8::gemm_phase((LAS unsigned char*)smem, g, S, E); }
        xcd_barrier(xb);
        phase_norm(p, l, 1);
        xcd_barrier(xb);
        { pg8::Gemm g{(const half_t*)(p.ws + OFF_BC), (const half_t*)(p.ws + OFF_WGU), MROWS, 2 * DFF, DM, DM, 0};
          S.init(g.M, g.N, (int)gridDim.x, (int)blockIdx.x, l == DEPTH - 1);
          EpiGU E{(half_t*)(p.ws + OFF_U)};
          pg8::gemm_phase((LAS unsigned char*)smem, g, S, E); }
        xcd_barrier(xb);
        { pg8::Gemm g{(const half_t*)(p.ws + OFF_U), (const half_t*)(p.ws + OFF_WDN), MROWS, DM, DFF, UST, 0};
          S.init(g.M, g.N, (int)gridDim.x, (int)blockIdx.x, (gridDim.x == 256 || l == DEPTH - 1) ? 1 : 0);
          EpiRes E{(const float*)p.out, (const float*)XC, p.out, XC, MODl + 5120};
          pg8::gemm_phase((LAS unsigned char*)smem, g, S, E);
          if (l + 1 < DEPTH && gridDim.x == 256) {
              const int item = (int)blockIdx.x, un = item >> 3, sl = item & 7;
              const int k0 = sl < 6 ? sl * 384 : 2304 + (sl - 6) * 256, kl = sl < 6 ? 384 : 256;
              pg8::Gemm gs{(const half_t*)(p.ws + OFF_U) + k0, (const half_t*)(p.ws + OFF_WDN) + k0, MROWS, DM, kl, UST, DFF};
              pg8::OneUnit S1{{(un >> 2) * 17, un & 3}};
              EpiPart EP{(float*)(p.ws + OFF_PART + (size_t)sl * SZ_PART1)};
              __syncthreads();
              pg8::gemm_phase((LAS unsigned char*)smem, gs, S1, EP);
          } }
        xcd_barrier(xb);
    }
    phase_final(p);
}

extern "C" void kernel_launch(void* const* d_in, const int* in_sizes, int n_in, void* d_out, int out_size, void* d_ws, size_t ws_size, hipStream_t stream) {
    static int grid_blocks = 0;
    if (grid_blocks == 0) {
        if (n_in != 33 || ws_size < WS_END) { fprintf(stderr, "kernel_launch: expected 33 inputs and >= %zu bytes of workspace; got %d inputs, %zu bytes\n", (size_t)WS_END, n_in, ws_size); grid_blocks = -1; return; }
        int dev = 0, cus = 0, per_cu = 0;
        hipGetDevice(&dev);
        hipDeviceGetAttribute(&cus, hipDeviceAttributeMultiprocessorCount, dev);
        if (hipFuncSetAttribute((const void*)fwd_megakernel, hipFuncAttributeMaxDynamicSharedMemorySize, LDS_BYTES) != hipSuccess) { fprintf(stderr, "kernel_launch: hipFuncSetAttribute failed\n"); grid_blocks = -1; return; }
        if (hipOccupancyMaxActiveBlocksPerMultiprocessor(&per_cu, (const void*)fwd_megakernel, 512, LDS_BYTES) != hipSuccess || per_cu < 1) { fprintf(stderr, "kernel_launch: occupancy query gave %d\n", per_cu); per_cu = 1; }
        (void)hipGetLastError();
        grid_blocks = cus * 1;
        if (grid_blocks > 256) grid_blocks = 256;
    }
    if (grid_blocks < 0) return;
    Params p{};
    for (int i = 0; i < 33; ++i) p.in[i] = (const float*)d_in[i];
    p.out = (float*)d_out; p.ws = (unsigned char*)d_ws;
    void* args[] = {&p};
    hipError_t e = hipLaunchCooperativeKernel((void*)fwd_megakernel, dim3(grid_blocks), dim3(512), args, LDS_BYTES, stream);
    if (e != hipSuccess) fprintf(stderr, "cooperative launch failed: %s (grid %d)\n", hipGetErrorString(e), grid_blocks);
}
```
